# Optimizing an MI355X kernel written in HIP

```python
import jax, jax.numpy as jnp
from jax import lax
import numpy as np


D_MODEL = 2048
BATCH = 4
SEQ = 8192
DEPTH = 1

D_FF = 5632
GLA_HEADS = 4
GLA_DK = 128
GLA_DV = 256
GLA_RANK = 16
GLA_TAU = 16.0
GLA_CHUNK = 64
MOBA_HEADS = 8
MOBA_HD = 128
MOBA_BLOCK = 256
MOBA_TOPK = 3
MOBA_QCHUNK = 16
NORM_EPS = 1e-6

GLA_QK_W = GLA_HEADS * GLA_DK
GLA_V_W = GLA_HEADS * GLA_DV
MOBA_W = MOBA_HEADS * MOBA_HD
IN_SPLITS = (GLA_QK_W, GLA_QK_W, GLA_V_W, GLA_V_W, GLA_RANK,
             MOBA_W, MOBA_W, MOBA_W, D_MODEL, D_MODEL)
D_IN = sum(IN_SPLITS)

kernel_name = 'hybrid_gla_moba_macaron_block'


def rms_norm(x, g):
    xf = x.astype(jnp.float32)
    y = xf * lax.rsqrt(jnp.mean(xf * xf, axis=-1, keepdims=True) + NORM_EPS)
    return (y * g.astype(jnp.float32)).astype(x.dtype)


def swiglu(h, w_gate, w_up, w_down):
    return (jax.nn.silu(h @ w_gate) * (h @ w_up)) @ w_down


def alibi_slopes(n):
    return jnp.exp2(-8.0 * jnp.arange(1, n + 1, dtype=jnp.float32) / n)


def gla_attention(q, k, v, log_a):
    B, S, H, dk = q.shape
    dv = v.shape[-1]
    C = GLA_CHUNK
    nc = S // C

    def to_chunks(t):
        return t.reshape(B, nc, C, H, t.shape[-1]).transpose(1, 0, 3, 2, 4)

    causal = jnp.tril(jnp.ones((C, C), dtype=bool))[None, None, :, :, None]

    def step(state, xs):
        qc, kc, vc, ac = xs
        b = jnp.cumsum(ac, axis=2)
        o_inter = jnp.einsum('bhck,bhkv->bhcv', qc * jnp.exp(b), state)
        diff = b[:, :, :, None, :] - b[:, :, None, :, :]
        decay = jnp.exp(jnp.where(causal, diff, -jnp.inf))
        attn = jnp.einsum('bhik,bhjk,bhijk->bhij', qc, kc, decay)
        o_intra = jnp.einsum('bhij,bhjv->bhiv', attn, vc)
        b_last = b[:, :, -1:, :]
        new_state = (jnp.exp(b_last[:, :, 0, :])[..., None] * state
                     + jnp.einsum('bhck,bhcv->bhkv', kc * jnp.exp(b_last - b), vc))
        return new_state, o_inter + o_intra

    state0 = jnp.zeros((B, H, dk, dv), jnp.float32)
    _, out = lax.scan(step, state0, (to_chunks(q), to_chunks(k), to_chunks(v), to_chunks(log_a)))
    return out.transpose(1, 0, 3, 2, 4).reshape(B, S, H, dv)


def moba_attention(q, k, v):
    B, S, H, hd = q.shape
    BLK, QC = MOBA_BLOCK, MOBA_QCHUNK
    nb = -(-S // BLK)
    s_pad = nb * BLK
    pad = ((0, 0), (0, s_pad - S), (0, 0), (0, 0))
    q, k, v = [jnp.pad(t, pad).transpose(0, 2, 1, 3) for t in (q, k, v)]
    kb = k.reshape(B, H, nb, BLK, hd)
    vb = v.reshape(B, H, nb, BLK, hd)
    k_mean = jnp.mean(kb.astype(jnp.float32), axis=3)

    pos = jnp.arange(s_pad, dtype=jnp.int32)
    q_blk = pos // BLK
    gate = jnp.einsum('bhsd,bhnd->bhsn', q.astype(jnp.float32), k_mean)
    past = jnp.arange(nb, dtype=jnp.int32)[None, :] < q_blk[:, None]
    gate = jnp.where(past, gate, -jnp.inf)
    k_sel = min(MOBA_TOPK, nb)
    _, sel_idx = lax.top_k(gate, k_sel)
    sel_valid = jnp.arange(k_sel, dtype=jnp.int32)[None, :] < q_blk[:, None]

    slopes = alibi_slopes(H)[None, :, None, None]
    scale = hd ** -0.5
    bi = jnp.arange(B)[:, None, None, None]
    hi = jnp.arange(H)[None, :, None, None]
    offs = jnp.arange(BLK, dtype=jnp.int32)

    def chunk(c):
        t0 = c * QC
        qc = lax.dynamic_slice_in_dim(q, t0, QC, axis=2)
        idx = lax.dynamic_slice_in_dim(sel_idx, t0, QC, axis=2)
        valid = lax.dynamic_slice_in_dim(sel_valid, t0, QC, axis=0)
        tq = t0 + jnp.arange(QC, dtype=jnp.int32)
        k_g = kb[bi, hi, idx]
        v_g = vb[bi, hi, idx]
        s_sel = jnp.einsum('bhqd,bhqrkd->bhqrk', qc, k_g,
                           preferred_element_type=jnp.float32) * scale
        dist_sel = (tq[:, None, None] - (idx[..., None] * BLK + offs)).astype(jnp.float32)
        s_sel = s_sel - slopes[..., None] * dist_sel
        s_sel = jnp.where(valid[None, None, :, :, None], s_sel, -jnp.inf)
        blk = t0 // BLK
        k_own = lax.dynamic_index_in_dim(kb, blk, axis=2, keepdims=False)
        v_own = lax.dynamic_index_in_dim(vb, blk, axis=2, keepdims=False)
        pos_own = blk * BLK + offs
        dist_own = (tq[:, None] - pos_own[None, :]).astype(jnp.float32)
        s_own = jnp.einsum('bhqd,bhkd->bhqk', qc, k_own,
                           preferred_element_type=jnp.float32) * scale - slopes * dist_own
        s_own = jnp.where(pos_own[None, :] <= tq[:, None], s_own, -jnp.inf)
        s = jnp.concatenate([s_sel.reshape(B, H, QC, k_sel * BLK), s_own], axis=-1)
        p = jax.nn.softmax(s, axis=-1).astype(v.dtype)
        p_sel = p[..., :k_sel * BLK].reshape(B, H, QC, k_sel, BLK)
        p_own = p[..., k_sel * BLK:]
        return (jnp.einsum('bhqrk,bhqrkd->bhqd', p_sel, v_g)
                + jnp.einsum('bhqk,bhkd->bhqd', p_own, v_own))

    out = lax.map(chunk, jnp.arange(s_pad // QC, dtype=jnp.int32))
    out = out.transpose(1, 0, 3, 2, 4).reshape(B, s_pad, H * hd)
    return out[:, :S]


def setup_inputs(seed: int = 0) -> dict:
    key = jax.random.key(seed)
    ks = jax.random.split(key, 20)

    def normal(k, shape, fan_in):
        return jax.random.normal(k, shape, jnp.float32) * fan_in ** -0.5

    def gain(k, shape):
        return 1.0 + 0.02 * jax.random.normal(k, shape, jnp.float32)

    L = DEPTH
    return {
        'x': jax.random.normal(ks[0], (BATCH, SEQ, D_MODEL), jnp.float32),
        'ffn1_norm': gain(ks[1], (L, D_MODEL)),
        'ffn1_w_gate': normal(ks[2], (L, D_MODEL, D_FF), D_MODEL),
        'ffn1_w_up': normal(ks[3], (L, D_MODEL, D_FF), D_MODEL),
        'ffn1_w_down': normal(ks[4], (L, D_FF, D_MODEL), D_FF),
        'mix_norm': gain(ks[5], (L, D_MODEL)),
        'w_in': normal(ks[6], (L, D_MODEL, D_IN), D_MODEL),
        'gla_w_alpha': normal(ks[7], (L, GLA_RANK, GLA_QK_W), GLA_RANK),
        'gla_b_alpha': 0.1 * jax.random.normal(ks[8], (L, GLA_QK_W), jnp.float32),
        'gla_out_norm': gain(ks[9], (L, GLA_DV)),
        'w_branch_gla': normal(ks[10], (L, GLA_V_W, D_MODEL), GLA_V_W),
        'w_branch_moba': normal(ks[11], (L, MOBA_W, D_MODEL), MOBA_W),
        'w_out': normal(ks[12], (L, D_MODEL, D_MODEL), D_MODEL),
        'ffn2_norm': gain(ks[13], (L, D_MODEL)),
        'ffn2_w_gate': normal(ks[14], (L, D_MODEL, D_FF), D_MODEL),
        'ffn2_w_up': normal(ks[15], (L, D_MODEL, D_FF), D_MODEL),
        'ffn2_w_down': normal(ks[16], (L, D_FF, D_MODEL), D_FF),
        'final_norm': gain(ks[17], (D_MODEL,)),
    }


def reference(x, ffn1_norm, ffn1_w_gate, ffn1_w_up, ffn1_w_down, mix_norm, w_in,
              gla_w_alpha, gla_b_alpha, gla_out_norm, w_branch_gla, w_branch_moba,
              w_out, ffn2_norm, ffn2_w_gate, ffn2_w_up, ffn2_w_down, final_norm):
    B, S, _ = x.shape
    split_at = np.cumsum(IN_SPLITS)[:-1].tolist()
    for l in range(DEPTH):
        x = x + 0.5 * swiglu(rms_norm(x, ffn1_norm[l]), ffn1_w_gate[l], ffn1_w_up[l], ffn1_w_down[l])

        h = rms_norm(x, mix_norm[l])
        proj = h @ w_in[l]
        g_q, g_k, g_v, g_r, g_lr, m_q, m_k, m_v, gate_a, gate_b = jnp.split(proj, split_at, axis=-1)

        log_a = jax.nn.log_sigmoid((g_lr @ gla_w_alpha[l] + gla_b_alpha[l]).astype(jnp.float32)) / GLA_TAU
        qa = g_q.astype(jnp.float32).reshape(B, S, GLA_HEADS, GLA_DK) * GLA_DK ** -0.5
        ka = g_k.astype(jnp.float32).reshape(B, S, GLA_HEADS, GLA_DK)
        va = g_v.astype(jnp.float32).reshape(B, S, GLA_HEADS, GLA_DV)
        oa = gla_attention(qa, ka, va, log_a.reshape(B, S, GLA_HEADS, GLA_DK))
        oa = rms_norm(oa, gla_out_norm[l]).astype(x.dtype)
        oa = oa.reshape(B, S, GLA_V_W) * jax.nn.silu(g_r)
        y_a = oa @ w_branch_gla[l]

        ob = moba_attention(m_q.reshape(B, S, MOBA_HEADS, MOBA_HD),
                            m_k.reshape(B, S, MOBA_HEADS, MOBA_HD),
                            m_v.reshape(B, S, MOBA_HEADS, MOBA_HD))
        y_b = ob @ w_branch_moba[l]

        y = (jax.nn.sigmoid(gate_a) * y_a + jax.nn.sigmoid(gate_b) * y_b) @ w_out[l]
        x = x + y

        x = x + 0.5 * swiglu(rms_norm(x, ffn2_norm[l]), ffn2_w_gate[l], ffn2_w_up[l], ffn2_w_down[l])
    return rms_norm(x, final_norm)
```

```cpp
#include <hip/hip_runtime.h>
#include <cstdio>
#include <cstdint>
namespace pg8 {
#define PG8_LAS __attribute__((address_space(3)))
typedef unsigned short bf16_t;
typedef short bf16x8 __attribute__((ext_vector_type(8)));
typedef float f32x4 __attribute__((ext_vector_type(4)));
typedef unsigned u32x4 __attribute__((ext_vector_type(4)));
constexpr int BM = 256, BK = 64, HALF = 128, HTB = HALF * BK * 2  , STAGE_BYTES = 8 * HTB, NXCD = 8, WGM = 8;

__host__ __device__ __forceinline__ int lds_byte(int r, int c) { const int st = (r >> 4) * 2 + (c >> 5), rr = r & 15, cc = c & 31, ob = rr * 64 + cc * 2; return st * 1024 + (ob ^ (((ob >> 9) & 1) << 5)); }
__host__ __device__ __forceinline__ void stage_rc(int b, int& R, int& C) { const int st = b / 1024, sb = b % 1024, swz = sb ^ (((sb >> 9) & 1) << 5); R = (st >> 1) * 16 + swz / 64; C = (st & 1) * 32 + (swz % 64) / 2; }
__host__ __device__ __forceinline__ int perm32(int rho) { const int n = rho >> 4, i = rho & 15; return 8 * (i >> 2) + 4 * n + (i & 3); }

struct Unit { int pm, pn; };
struct Gemm { const bf16_t* A; const bf16_t* Bt; int M, N, K; };

struct StaticOrder {
    int nM, nN, nwg, G, c;
    __host__ __device__ void init(int M, int N, int G_, int c_) { nM = M / BM; nN = N / BM; nwg = nM * nN; G = G_; c = c_; }
    __host__ __device__ bool next(int i, Unit& u) const {
        const long L = (long)i * G + c; if (L >= nwg) return false;
        int wgid = (int)L; { const int q = nwg / NXCD, r = nwg % NXCD, xcd = wgid % NXCD, off = wgid / NXCD; wgid = (xcd < r ? xcd * (q + 1) : r * (q + 1) + (xcd - r) * q) + off; }
        const int nig = WGM * nN, gid = wgid / nig, fm = gid * WGM, gsz = (nM - fm) < WGM ? (nM - fm) : WGM;
        u.pm = fm + ((wgid % nig) % gsz); u.pn = (wgid % nig) / gsz; return true;
    }
    __device__ __forceinline__ void a_ready(const Unit&) const {}
    __device__ __forceinline__ void done(const Unit&) const {}
};

typedef float f32x2_t __attribute__((ext_vector_type(2))); typedef __bf16 bf16x2_t __attribute__((ext_vector_type(2)));
__device__ __forceinline__ unsigned cvt_pk_bf16(float lo, float hi) { f32x2_t v = {lo, hi}; bf16x2_t b = __builtin_convertvector(v, bf16x2_t); return __builtin_bit_cast(unsigned, b); }
__device__ __forceinline__ float fast_sigmoid(float x) { return __builtin_amdgcn_rcpf(1.0f + __builtin_amdgcn_exp2f(-1.4426950408889634f * x)); }
__device__ __forceinline__ float fast_silu(float x) { return x * fast_sigmoid(x); }
__device__ __forceinline__ float bf_lo(unsigned w) { return __builtin_bit_cast(float, w << 16); }
__device__ __forceinline__ float bf_hi(unsigned w) { return __builtin_bit_cast(float, w & 0xffff0000u); }

struct EpiSwiGLU {
    static constexpr bool PERM = true, AFTER_DRAIN = false;
    bf16_t* H; int ldh;
    __device__ __forceinline__ void operator()(const f32x4 (&acc)[2][2][4][2], const Unit& u, int wr, int wc, int fr, int fq) const {
        const int row0 = u.pm * BM + wr * 64 + fr, col0 = u.pn * HALF + wc * 32 + 8 * fq;
#pragma unroll
        for (int ai = 0; ai < 2; ++ai)
#pragma unroll
            for (int m = 0; m < 4; ++m) { bf16_t* rowp = H + (size_t)(row0 + ai * HALF + m * 16) * ldh + col0;
                const f32x4 g0 = acc[ai][0][m][0], g1 = acc[ai][0][m][1], u0 = acc[ai][1][m][0], u1 = acc[ai][1][m][1];
                u32x4 w; w.x = cvt_pk_bf16(fast_silu(g0[0]) * u0[0], fast_silu(g0[1]) * u0[1]); w.y = cvt_pk_bf16(fast_silu(g0[2]) * u0[2], fast_silu(g0[3]) * u0[3]);
                w.z = cvt_pk_bf16(fast_silu(g1[0]) * u1[0], fast_silu(g1[1]) * u1[1]); w.w = cvt_pk_bf16(fast_silu(g1[2]) * u1[2], fast_silu(g1[3]) * u1[3]);
                *(u32x4*)rowp = w; }
    }
};
struct EpiResid {
    static constexpr bool PERM = false, AFTER_DRAIN = false;
    const float* R; float* O; int ld; float alpha;
    __device__ __forceinline__ void operator()(const f32x4 (&acc)[2][2][4][2], const Unit& u, int wr, int wc, int fr, int fq) const {
        const int row0 = u.pm * BM + wr * 64 + fr, col0 = u.pn * BM + wc * 32 + 4 * fq;
#pragma unroll
        for (int ai = 0; ai < 2; ++ai)
#pragma unroll
            for (int m = 0; m < 4; ++m) { const size_t off = (size_t)(row0 + ai * HALF + m * 16) * ld + col0;
#pragma unroll
                for (int bj = 0; bj < 2; ++bj)
#pragma unroll
                    for (int n = 0; n < 2; ++n) { const f32x4 r = *(const f32x4*)(R + off + bj * HALF + n * 16); *(f32x4*)(O + off + bj * HALF + n * 16) = r + acc[ai][bj][m][n] * alpha; } }
    }
};
struct EpiProj {
    static constexpr bool PERM = true, AFTER_DRAIN = false;
    unsigned char* base;
    __device__ __forceinline__ void operator()(const f32x4 (&acc)[2][2][4][2], const Unit& u, int wr, int wc, int fr, int fq) const {
        const int pn = u.pn; const int row0 = u.pm * BM + wr * 64 + fr;
        if (pn == 40) {
            if (wc == 0 && fq < 2) { float* G = (float*)(base + (size_t)640 * 1048576);
#pragma unroll
                for (int ai = 0; ai < 2; ++ai)
#pragma unroll
                    for (int m = 0; m < 4; ++m) { float* rowp = G + (size_t)(row0 + ai * HALF + m * 16) * 16 + 8 * fq; *(f32x4*)rowp = acc[ai][0][m][0]; *(f32x4*)(rowp + 4) = acc[ai][0][m][1]; } }
            return;
        }
        size_t boff; int ld, t0, act = 0;
        if (pn < 2) { boff = 0; ld = 512; t0 = 0; } else if (pn < 4) { boff = 32; ld = 512; t0 = 2; } else if (pn < 8) { boff = 64; ld = 1024; t0 = 4; }
        else if (pn < 12) { boff = 128; ld = 1024; t0 = 8; act = 1; } else if (pn < 16) { boff = 192; ld = 1024; t0 = 12; } else if (pn < 20) { boff = 256; ld = 1024; t0 = 16; }
        else if (pn < 24) { boff = 320; ld = 1024; t0 = 20; } else if (pn < 32) { boff = 384; ld = 2048; t0 = 24; act = 2; } else { boff = 512; ld = 2048; t0 = 32; act = 2; }
        bf16_t* O = (bf16_t*)(base + boff * 1048576); const int col0 = (pn - t0) * BM + wc * 32 + 8 * fq;
#pragma unroll
        for (int ai = 0; ai < 2; ++ai)
#pragma unroll
            for (int m = 0; m < 4; ++m) { bf16_t* rowp = O + (size_t)(row0 + ai * HALF + m * 16) * ld + col0;
#pragma unroll
                for (int bj = 0; bj < 2; ++bj) { f32x4 v0 = acc[ai][bj][m][0], v1 = acc[ai][bj][m][1];
                    if (act == 1) {
#pragma unroll
                        for (int j = 0; j < 4; ++j) { v0[j] = fast_silu(v0[j]); v1[j] = fast_silu(v1[j]); } }
                    else if (act == 2) {
#pragma unroll
                        for (int j = 0; j < 4; ++j) { v0[j] = fast_sigmoid(v0[j]); v1[j] = fast_sigmoid(v1[j]); } }
                    u32x4 w; w.x = cvt_pk_bf16(v0[0], v0[1]); w.y = cvt_pk_bf16(v0[2], v0[3]); w.z = cvt_pk_bf16(v1[0], v1[1]); w.w = cvt_pk_bf16(v1[2], v1[3]);
                    *(u32x4*)(rowp + bj * HALF) = w; } }
    }
};
template <bool ACCUM> struct EpiGateMul {
    static constexpr bool PERM = true, AFTER_DRAIN = false;
    const bf16_t* G; bf16_t* Y; int ld;
    __device__ __forceinline__ void operator()(const f32x4 (&acc)[2][2][4][2], const Unit& u, int wr, int wc, int fr, int fq) const {
        const int row0 = u.pm * BM + wr * 64 + fr, col0 = u.pn * BM + wc * 32 + 8 * fq;
#pragma unroll
        for (int ai = 0; ai < 2; ++ai)
#pragma unroll
            for (int m = 0; m < 4; ++m) { const size_t off = (size_t)(row0 + ai * HALF + m * 16) * ld + col0;
#pragma unroll
                for (int bj = 0; bj < 2; ++bj) { const f32x4 a0 = acc[ai][bj][m][0], a1 = acc[ai][bj][m][1];
                    const u32x4 g = *(const u32x4*)(G + off + bj * HALF);
                    float v[8] = {bf_lo(g.x) * a0[0], bf_hi(g.x) * a0[1], bf_lo(g.y) * a0[2], bf_hi(g.y) * a0[3], bf_lo(g.z) * a1[0], bf_hi(g.z) * a1[1], bf_lo(g.w) * a1[2], bf_hi(g.w) * a1[3]};
                    if (ACCUM) { const u32x4 y = *(const u32x4*)(Y + off + bj * HALF);
                        v[0] += bf_lo(y.x); v[1] += bf_hi(y.x); v[2] += bf_lo(y.y); v[3] += bf_hi(y.y); v[4] += bf_lo(y.z); v[5] += bf_hi(y.z); v[6] += bf_lo(y.w); v[7] += bf_hi(y.w); }
                    u32x4 w; w.x = cvt_pk_bf16(v[0], v[1]); w.y = cvt_pk_bf16(v[2], v[3]); w.z = cvt_pk_bf16(v[4], v[5]); w.w = cvt_pk_bf16(v[6], v[7]);
                    *(u32x4*)(Y + off + bj * HALF) = w; } }
    }
};

template <class Epi, class Sched, bool ALIGN_EPI = false, bool SP2 = false>
__device__ __forceinline__ void gemm_phase(PG8_LAS unsigned char* lds, const Gemm g, const Sched& S, const Epi& E) {
    const int tid = threadIdx.x, wid = __builtin_amdgcn_readfirstlane(tid >> 6), lane = tid & 63, wr = wid >> 2, wc = wid & 3, fr = lane & 15, fq = lane >> 4;
    const int K = g.K, nt = K / BK;
    unsigned voffA[2], voffB[2];
#pragma unroll
    for (int i = 0; i < 2; ++i) { int R, C; stage_rc(tid * 16 + i * 8192, R, C); const int Rb = Epi::PERM ? ((R & ~31) + perm32(R & 31)) : R;
        voffA[i] = (unsigned)(R * K + C) * 2u; voffB[i] = (unsigned)(Rb * K + C) * 2u; }
    const size_t kstep = (size_t)(BK * 2);
    const size_t hstep = (size_t)HALF * K * 2;
    const size_t tstep = 2 * hstep;
    const unsigned ldsw = (unsigned)wid * 1024u;
    const int aoff = lds_byte(wr * 64 + fr, fq * 8), boff = lds_byte(wc * 32 + fr, fq * 8);
#define PG8_SA(b, h) (((b) * 2 + (h)) * HTB)
#define PG8_SB(b, h) ((4 + (b) * 2 + (h)) * HTB)
#define PG8_STAGE(bufoff, gbase, voff) do { _Pragma("unroll") for (int _i = 0; _i < 2; ++_i) \
        __builtin_amdgcn_global_load_lds((const unsigned*)((const char*)(gbase) + (voff)[_i]), (PG8_LAS unsigned*)(lds + (bufoff) + ldsw + _i * 8192), 16, 0, 0); } while (0)
#define PG8_LDA(dst, b, h) do { _Pragma("unroll") for (int m = 0; m < 4; ++m) _Pragma("unroll") for (int k = 0; k < 2; ++k) dst[m][k] = *(const PG8_LAS bf16x8*)(lds + PG8_SA(b, h) + aoff + m * 2048 + k * 1024); } while (0)
#define PG8_LDB(dst, b, h) do { _Pragma("unroll") for (int n = 0; n < 2; ++n) _Pragma("unroll") for (int k = 0; k < 2; ++k) dst[n][k] = *(const PG8_LAS bf16x8*)(lds + PG8_SB(b, h) + boff + n * 2048 + k * 1024); } while (0)
#define PG8_MMA(ai, bj, At, Bt) do { __builtin_amdgcn_s_setprio(1); _Pragma("unroll") for (int m = 0; m < 4; ++m) _Pragma("unroll") for (int n = 0; n < 2; ++n) _Pragma("unroll") for (int k = 0; k < 2; ++k) \
        acc[ai][bj][m][n] = __builtin_amdgcn_mfma_f32_16x16x32_bf16(Bt[n][k], At[m][k], acc[ai][bj][m][n], 0, 0, 0); __builtin_amdgcn_s_setprio(0); } while (0)
#define PG8_WAIT_V(n) asm volatile("s_waitcnt vmcnt(" #n ")" ::: "memory")
#define PG8_WAIT_L(n) asm volatile("s_waitcnt lgkmcnt(" #n ")" ::: "memory")
#define PG8_BAR __builtin_amdgcn_s_barrier()
#define PG8_SCHED __builtin_amdgcn_sched_barrier(0)
    Unit cur, nxt; int ui = 0;
    if (!S.next(0, cur)) return;
    f32x4 acc[2][2][4][2];
#pragma unroll
    for (int a = 0; a < 2; ++a)
#pragma unroll
        for (int b = 0; b < 2; ++b)
#pragma unroll
            for (int m = 0; m < 4; ++m)
#pragma unroll
                for (int n = 0; n < 2; ++n) acc[a][b][m][n] = (f32x4){0.f, 0.f, 0.f, 0.f};
    bf16x8 At[4][2], B0[2][2], B1[2][2];
    const char* cA = (const char*)g.A + (size_t)cur.pm * tstep; const char* cB = (const char*)g.Bt + (size_t)cur.pn * tstep;
    S.a_ready(cur);
    if constexpr (SP2) {
        PG8_STAGE(PG8_SB(0, 0), cB, voffB); PG8_STAGE(PG8_SB(0, 1), cB + hstep, voffB); PG8_STAGE(PG8_SA(0, 0), cA, voffA); PG8_STAGE(PG8_SA(0, 1), cA + hstep, voffA);
        if (wr == 1) PG8_BAR;
        PG8_WAIT_V(2); PG8_BAR;
        PG8_STAGE(PG8_SB(1, 0), cB + kstep, voffB); PG8_STAGE(PG8_SA(1, 0), cA + kstep, voffA); PG8_STAGE(PG8_SB(1, 1), cB + hstep + kstep, voffB);
        PG8_WAIT_V(6); PG8_BAR;
    } else {
        PG8_STAGE(PG8_SB(0, 0), cB, voffB); PG8_STAGE(PG8_SA(0, 0), cA, voffA); PG8_STAGE(PG8_SB(0, 1), cB + hstep, voffB); PG8_STAGE(PG8_SA(0, 1), cA + hstep, voffA);
        if (wr == 1) PG8_BAR;
        PG8_WAIT_V(4); PG8_BAR;
        PG8_STAGE(PG8_SB(1, 0), cB + kstep, voffB); PG8_STAGE(PG8_SA(1, 0), cA + kstep, voffA); PG8_STAGE(PG8_SB(1, 1), cB + hstep + kstep, voffB);
        PG8_WAIT_V(6); PG8_BAR;
    }
    for (;;) {
        const bool has_next = S.next(ui + 1, nxt);
        const char* nA = has_next ? (const char*)g.A + (size_t)nxt.pm * tstep : cA; const char* nB = has_next ? (const char*)g.Bt + (size_t)nxt.pn * tstep : cB;
        for (int t = 0; t < nt; t += 2) {
            const bool last = (t == nt - 2);
            const char* a1 = cA + (size_t)(t + 1) * kstep;
            const char* a2 = last ? nA : cA + (size_t)(t + 2) * kstep; const char* b2 = last ? nB : cB + (size_t)(t + 2) * kstep;
            const char* a3 = a2 + kstep; const char* b3 = b2 + kstep;
            if (last && has_next) S.a_ready(nxt);
            if constexpr (SP2) {
            PG8_LDB(B0, 0, 0); PG8_LDB(B1, 0, 1); PG8_SCHED; PG8_LDA(At, 0, 0); PG8_STAGE(PG8_SA(1, 1), a1 + hstep, voffA);
            PG8_WAIT_V(8); PG8_WAIT_L(0); PG8_BAR; PG8_MMA(0, 0, At, B0); PG8_MMA(0, 1, At, B1); PG8_BAR; PG8_SCHED;
            PG8_LDA(At, 0, 1); PG8_STAGE(PG8_SB(0, 0), b2, voffB); PG8_STAGE(PG8_SB(0, 1), b2 + hstep, voffB); PG8_STAGE(PG8_SA(0, 0), a2, voffA);
            PG8_WAIT_V(8); PG8_WAIT_L(0); PG8_BAR; PG8_MMA(1, 0, At, B0); PG8_MMA(1, 1, At, B1); PG8_BAR; PG8_SCHED;
            PG8_LDB(B0, 1, 0); PG8_LDB(B1, 1, 1); PG8_SCHED; PG8_LDA(At, 1, 0); PG8_STAGE(PG8_SA(0, 1), a2 + hstep, voffA);
            PG8_WAIT_V(8); PG8_WAIT_L(0); PG8_BAR; PG8_MMA(0, 0, At, B0); PG8_MMA(0, 1, At, B1); PG8_BAR; PG8_SCHED;
            PG8_LDA(At, 1, 1); PG8_STAGE(PG8_SB(1, 0), b3, voffB); PG8_STAGE(PG8_SB(1, 1), b3 + hstep, voffB); PG8_STAGE(PG8_SA(1, 0), a3, voffA);
            PG8_WAIT_V(8); PG8_WAIT_L(0); PG8_BAR; PG8_MMA(1, 0, At, B0); PG8_MMA(1, 1, At, B1); PG8_BAR; PG8_SCHED;
            } else {
            PG8_LDB(B0, 0, 0); PG8_SCHED; PG8_LDA(At, 0, 0); PG8_STAGE(PG8_SA(1, 1), a1 + hstep, voffA);
            PG8_WAIT_L(8); PG8_BAR; PG8_WAIT_L(0); PG8_MMA(0, 0, At, B0); PG8_BAR; PG8_SCHED;
            PG8_LDB(B1, 0, 1); PG8_STAGE(PG8_SB(0, 0), b2, voffB);
            PG8_BAR; PG8_WAIT_L(0); PG8_MMA(0, 1, At, B1); PG8_BAR;
            PG8_LDA(At, 0, 1); PG8_STAGE(PG8_SA(0, 0), a2, voffA);
            PG8_BAR; PG8_WAIT_L(0); PG8_MMA(1, 0, At, B0); PG8_BAR; PG8_SCHED;
            PG8_STAGE(PG8_SB(0, 1), b2 + hstep, voffB);
            PG8_WAIT_V(6); PG8_BAR; PG8_MMA(1, 1, At, B1); PG8_BAR;
            PG8_LDB(B0, 1, 0); PG8_SCHED; PG8_LDA(At, 1, 0); PG8_STAGE(PG8_SA(0, 1), a2 + hstep, voffA);
            PG8_WAIT_L(8); PG8_BAR; PG8_WAIT_L(0); PG8_MMA(0, 0, At, B0); PG8_BAR; PG8_SCHED;
            PG8_LDB(B1, 1, 1); PG8_STAGE(PG8_SB(1, 0), b3, voffB);
            PG8_BAR; PG8_WAIT_L(0); PG8_MMA(0, 1, At, B1); PG8_BAR;
            PG8_LDA(At, 1, 1); PG8_STAGE(PG8_SA(1, 0), a3, voffA);
            PG8_BAR; PG8_WAIT_L(0); PG8_MMA(1, 0, At, B0); PG8_BAR; PG8_SCHED;
            PG8_STAGE(PG8_SB(1, 1), b3 + hstep, voffB);
            PG8_WAIT_V(6); PG8_BAR; PG8_MMA(1, 1, At, B1); PG8_BAR;
            }
        }
        if constexpr (ALIGN_EPI) { if (wr == 0) PG8_BAR; }
        if constexpr (!Epi::AFTER_DRAIN) { E(acc, cur, wr, wc, fr, fq); S.done(cur); }
        if (!has_next) break;
#pragma unroll
        for (int a = 0; a < 2; ++a)
#pragma unroll
            for (int b = 0; b < 2; ++b)
#pragma unroll
                for (int m = 0; m < 4; ++m)
#pragma unroll
                    for (int n = 0; n < 2; ++n) acc[a][b][m][n] = (f32x4){0.f, 0.f, 0.f, 0.f};
        cur = nxt; cA = nA; cB = nB; ++ui;
        if constexpr (ALIGN_EPI) { if (wr == 1) PG8_BAR; }
    }
    PG8_WAIT_V(0);
    if constexpr (!ALIGN_EPI) { if (wr == 0) PG8_BAR; }
    PG8_BAR;
    if constexpr (Epi::AFTER_DRAIN) { E.fused(acc, cur, wr, wc, fr, fq, lds, wid, lane); S.done(cur); }
#undef PG8_SA
#undef PG8_SB
#undef PG8_STAGE
#undef PG8_LDA
#undef PG8_LDB
#undef PG8_MMA
#undef PG8_WAIT_V
#undef PG8_WAIT_L
#undef PG8_BAR
#undef PG8_SCHED
}
}

#define GAS __attribute__((address_space(1)))
#define LAS __attribute__((address_space(3)))
typedef unsigned short bf16;
typedef unsigned v4u __attribute__((ext_vector_type(4)));
typedef float f32x4 __attribute__((ext_vector_type(4)));
typedef short bf16x8 __attribute__((ext_vector_type(8)));
typedef GAS unsigned gu32;
typedef GAS unsigned long long gu64;
#define RLX_AGENT __ATOMIC_RELAXED, __HIP_MEMORY_SCOPE_AGENT
#define LDS_WAIT() asm volatile("s_waitcnt lgkmcnt(0)" ::: "memory")
#define VM_WAIT() asm volatile("s_waitcnt vmcnt(0)" ::: "memory")
__device__ __forceinline__ unsigned long long rt() { return __builtin_amdgcn_s_memrealtime(); }
__device__ __forceinline__ unsigned f2bf(float f) { unsigned u = __builtin_bit_cast(unsigned, f); return (u + 0x7fffu + ((u >> 16) & 1u)) >> 16; }
__device__ __forceinline__ unsigned pk2(float lo, float hi) { return f2bf(lo) | (f2bf(hi) << 16); }

#define XB_TMO      128
#define XB_XCNT(j)  (256  + 64 * (j))
#define XB_XSUB(j)  (1280 + 64 * (j))
#define XB_XGEN(j)  (2304 + 64 * (j))
#define XB_TOP      3328
#define XB_TOPGEN   3392
#define XCD_BAR_WORDS 3456
#define XB_SPIN_CAP (1u << 18)

__device__ __forceinline__ unsigned xb_ld(unsigned* p)              { return __hip_atomic_load(p, __ATOMIC_RELAXED, __HIP_MEMORY_SCOPE_AGENT); }
__device__ __forceinline__ unsigned xb_add(unsigned* p, unsigned v) { return __hip_atomic_fetch_add(p, v, __ATOMIC_RELAXED, __HIP_MEMORY_SCOPE_AGENT); }
__device__ __forceinline__ unsigned xb_xcc_id() { return (unsigned)__builtin_amdgcn_s_getreg((3 << 11) | 20) & 0xFu; }
#define XB_SPIN(cond, bar) do { unsigned _sp = 0; while (cond) { __builtin_amdgcn_s_sleep(1); \
    if ((++_sp & 255u) == 0u) { if (xb_ld(&(bar)[XB_TMO])) break; if (_sp > XB_SPIN_CAP) { atomicAdd(&(bar)[XB_TMO], 1u); break; } } } } while (0)

struct XcdBarrier {
    unsigned* bar; unsigned x;
    volatile LAS unsigned* st;
};

__device__ __forceinline__ XcdBarrier xcd_barrier_post(unsigned* bar, volatile LAS unsigned* st) {
    XcdBarrier b; b.bar = bar; b.x = xb_xcc_id(); b.st = st;
    if (threadIdx.x == 0) (void)xb_add(&bar[XB_XCNT(b.x)], 1u);
    return b;
}
__device__ __forceinline__ void xcd_barrier_complete(unsigned* bar, unsigned x, unsigned& nloc, unsigned& nx) {
    const unsigned G = gridDim.x * gridDim.y * gridDim.z;
    unsigned sum, cnt, mine, sp = 0u;
    for (;;) {
        sum = 0u; cnt = 0u; mine = 0u;
#pragma unroll
        for (unsigned j = 0; j < 16; ++j) { const unsigned c = xb_ld(&bar[XB_XCNT(j)]); sum += c; cnt += (c > 0u) ? 1u : 0u; mine = (j == x) ? c : mine; }
        if (sum == G) break;
        __builtin_amdgcn_s_sleep(1);
        if ((++sp & 255u) == 0u) { if (xb_ld(&bar[XB_TMO])) break; if (sp > XB_SPIN_CAP) { atomicAdd(&bar[XB_TMO], 1u); break; } }
    }
    nloc = mine > 0u ? mine : 1u; nx = cnt > 0u ? cnt : 1u;
}

__device__ __forceinline__ void xcd_barrier(const XcdBarrier& b) {
    asm volatile("s_waitcnt vmcnt(0)" ::: "memory");
    __syncthreads();
    if (threadIdx.x == 0) {
        unsigned* bar = b.bar;
        __builtin_amdgcn_s_waitcnt(0);
        unsigned nloc = b.st[0], nx = b.st[1];
        if (nloc == 0u) { xcd_barrier_complete(bar, b.x, nloc, nx); b.st[0] = nloc; b.st[1] = nx; }
        const unsigned old = xb_add(&bar[XB_XSUB(b.x)], 1u);
        const unsigned gen = old / nloc;
        if (old + 1u == (gen + 1u) * nloc) {
            __builtin_amdgcn_fence(__ATOMIC_RELEASE, "agent");
            asm volatile("s_waitcnt vmcnt(0)" ::: "memory");
            const unsigned og = xb_add(&bar[XB_TOP], 1u);
            const unsigned tg = og / nx;
            if (og + 1u == (tg + 1u) * nx) xb_add(&bar[XB_TOPGEN], 1u);
            else XB_SPIN(xb_ld(&bar[XB_TOPGEN]) == tg, bar);
            __builtin_amdgcn_fence(__ATOMIC_ACQUIRE, "agent");
            xb_add(&bar[XB_XGEN(b.x)], 1u);
            asm volatile("s_waitcnt vmcnt(0)" ::: "memory");
        } else {
            XB_SPIN(xb_ld(&bar[XB_XGEN(b.x)]) == gen, bar);
            __builtin_amdgcn_fence(__ATOMIC_ACQUIRE, "agent");
            asm volatile("s_waitcnt vmcnt(0)" ::: "memory");
        }
    }
    __syncthreads();
}
constexpr int NWAVES = 8;
constexpr int BATCH = 4, SEQ = 8192, DM = 2048, DFF = 5632, M = BATCH * SEQ;
constexpr int GLA_H = 4, GLA_DK = 128, GLA_DV = 256, GLA_RANK = 16;
constexpr int MOBA_H = 8, MOBA_HD = 128, MOBA_BLK = 256, MOBA_NB = SEQ / MOBA_BLK;
constexpr int D_IN = 10256, NPROJ = 10496;
constexpr float NORM_EPS = 1e-6f;
#ifndef MK_NO_GLA
#define MK_NO_GLA 0
#endif
#ifndef MK_NO_MOBA
#define MK_NO_MOBA 0
#endif
#ifndef MK_PER_PHASE
#define MK_PER_PHASE 0
#endif
constexpr int N_PHASES = 14;

constexpr size_t MiB = 1u << 20;
constexpr size_t WS_CTL = 0, CTL_ZERO_BYTES = 1 * MiB;
constexpr size_t WS_WGU = 1 * MiB;
constexpr size_t WS_WD = 45 * MiB;
constexpr size_t WS_WIN = 67 * MiB;
constexpr size_t WS_WBG = 108 * MiB;
constexpr size_t WS_WBM = 112 * MiB;
constexpr size_t WS_WO = 116 * MiB;
constexpr size_t WS_XN = 124 * MiB;
constexpr size_t WS_R1 = 252 * MiB;
constexpr size_t WS_GLAS = 894 * MiB;
constexpr size_t WS_MISC = 958 * MiB;
constexpr size_t WS_END = 962 * MiB;
constexpr size_t R1_GQ = 0, R1_GK = 32 * MiB, R1_GV = 64 * MiB, R1_GR = 128 * MiB, R1_MQ = 192 * MiB, R1_MK = 256 * MiB, R1_MV = 320 * MiB, R1_GA = 384 * MiB, R1_GB = 512 * MiB, R1_GLR = 640 * MiB;
constexpr size_t MISC_DEC = 0, MISC_KMEAN = 1 * MiB, MISC_SEL = 2 * MiB;
constexpr int CW_TMO = 0, CW_CODE = 1, CW_BAR = 4096;

constexpr int RING_OFF = 0, RING_BYTES = 131072;
constexpr int LDSCTL_OFF = 147456 - 512, MISC_OFF = LDSCTL_OFF + 320;
constexpr int LDS_BYTES = 147456;

struct Frame {
    LAS unsigned char* lds;
    volatile LAS unsigned* MISC;
    gu32* ctl;
    int tid, lane, wave, vcu, G;
};
__device__ __forceinline__ float wave_sum(float v) {
#pragma unroll
    for (int o = 1; o < 64; o <<= 1) v += __shfl_xor(v, o);
    return v;
}
template <class MAP>
__device__ __forceinline__ void transpose_item(const float* W, int K, int N, bf16* WT, const MAP& map, LAS float* scr, int item, int lane) {
    const int nblk = (N + 31) / 32, kb = item / nblk, nb = item % nblk, k0 = 64 * kb, n0 = 32 * nb;
    const bool ldok = n0 + (lane & 31) < N;
#pragma unroll 8
    for (int i = 0; i < 32; ++i) { const int kk = 2 * i + (lane >> 5); scr[kk * 33 + (lane & 31)] = ldok ? W[(size_t)(k0 + kk) * N + n0 + (lane & 31)] : 0.f; }
    LDS_WAIT(); asm volatile("" ::: "memory");
    const int c = lane & 7;
#pragma unroll
    for (int j = 0; j < 4; ++j) { const int n = (lane >> 3) + 8 * j; const LAS float* s = scr + (8 * c) * 33 + n;
        v4u o; o.x = pk2(s[0 * 33], s[1 * 33]); o.y = pk2(s[2 * 33], s[3 * 33]); o.z = pk2(s[4 * 33], s[5 * 33]); o.w = pk2(s[6 * 33], s[7 * 33]);
        if (n0 + n < N) *(GAS v4u*)(WT + (size_t)map(n0 + n) * K + k0 + 8 * c) = o; }
    LDS_WAIT(); asm volatile("" ::: "memory");
}
struct MapId { __device__ __forceinline__ int operator()(int n) const { return n; } };
struct MapGU { int up; __device__ __forceinline__ int operator()(int n) const { return 256 * (n >> 7) + 128 * up + (n & 127); } };
struct MapIn { __device__ __forceinline__ int operator()(int n) const { return n < 3072 ? n : (n < 3088 ? 10240 + (n - 3072) : n - 16); } };
template <class MAP>
__device__ __forceinline__ void transpose_weight(Frame& F, const float* W, int K, int N, bf16* WT, const MAP& map, int& cursor) {
    LAS float* scr = (LAS float*)(F.lds + RING_OFF + F.wave * 16384);
    const int gw = F.vcu * NWAVES + F.wave, NGW = F.G * NWAVES;
    const int nitems = (K / 64) * ((N + 31) / 32);
    int first = (gw - cursor) % NGW; if (first < 0) first += NGW;
    for (int it = first; it < nitems; it += NGW) transpose_item(W, K, N, WT, map, scr, it, F.lane);
    cursor = (cursor + nitems) % NGW;
}
__device__ __forceinline__ void rms_rows_bf16(Frame& F, const float* X, const float* g, bf16* O) {
    const int gw = F.vcu * NWAVES + F.wave, NGW = F.G * NWAVES;
    f32x4 gv[8];
#pragma unroll
    for (int j = 0; j < 4; ++j) { gv[2 * j] = *(const GAS f32x4*)(g + 512 * j + 8 * F.lane); gv[2 * j + 1] = *(const GAS f32x4*)(g + 512 * j + 8 * F.lane + 4); }
    for (int m = gw; m < M; m += NGW) {
        const float* xr = X + (size_t)m * DM + 8 * F.lane;
        f32x4 v[8]; float s = 0.f;
#pragma unroll
        for (int j = 0; j < 4; ++j) { v[2 * j] = *(const GAS f32x4*)(xr + 512 * j); v[2 * j + 1] = *(const GAS f32x4*)(xr + 512 * j + 4); }
#pragma unroll
        for (int j = 0; j < 8; ++j) s += (v[j].x * v[j].x + v[j].y * v[j].y) + (v[j].z * v[j].z + v[j].w * v[j].w);
        const float r = 1.0f / sqrtf(wave_sum(s) * (1.0f / DM) + NORM_EPS);
        bf16* orow = O + (size_t)m * DM + 8 * F.lane;
#pragma unroll
        for (int j = 0; j < 4; ++j) { const f32x4 a = v[2 * j] * gv[2 * j] * r, b = v[2 * j + 1] * gv[2 * j + 1] * r;
            v4u o; o.x = pk2(a.x, a.y); o.y = pk2(a.z, a.w); o.z = pk2(b.x, b.y); o.w = pk2(b.z, b.w); *(GAS v4u*)(orow + 512 * j) = o; }
    }
}
__device__ __forceinline__ void rms_rows_f32_inplace(Frame& F, float* X, const float* g) {
    const int gw = F.vcu * NWAVES + F.wave, NGW = F.G * NWAVES;
    f32x4 gv[8];
#pragma unroll
    for (int j = 0; j < 4; ++j) { gv[2 * j] = *(const GAS f32x4*)(g + 512 * j + 8 * F.lane); gv[2 * j + 1] = *(const GAS f32x4*)(g + 512 * j + 8 * F.lane + 4); }
    for (int m = gw; m < M; m += NGW) {
        float* xr = X + (size_t)m * DM + 8 * F.lane;
        f32x4 v[8]; float s = 0.f;
#pragma unroll
        for (int j = 0; j < 4; ++j) { v[2 * j] = *(const GAS f32x4*)(xr + 512 * j); v[2 * j + 1] = *(const GAS f32x4*)(xr + 512 * j + 4); }
#pragma unroll
        for (int j = 0; j < 8; ++j) s += (v[j].x * v[j].x + v[j].y * v[j].y) + (v[j].z * v[j].z + v[j].w * v[j].w);
        const float r = 1.0f / sqrtf(wave_sum(s) * (1.0f / DM) + NORM_EPS);
#pragma unroll
        for (int j = 0; j < 4; ++j) { *(GAS f32x4*)(xr + 512 * j) = v[2 * j] * gv[2 * j] * r; *(GAS f32x4*)(xr + 512 * j + 4) = v[2 * j + 1] * gv[2 * j + 1] * r; }
    }
}
__device__ __forceinline__ void zero_rows_bf16(Frame& F, bf16* P, size_t nbytes) {
    const size_t n16 = nbytes / 16; GAS v4u* p = (GAS v4u*)P;
    for (size_t i = (size_t)F.vcu * (NWAVES * 64) + F.tid; i < n16; i += (size_t)F.G * NWAVES * 64) p[i] = (v4u){0u, 0u, 0u, 0u};
}

namespace gla {
using bf16x8 = __attribute__((ext_vector_type(8))) short;
using s16x4  = __attribute__((ext_vector_type(4))) short;
using f32x16 = __attribute__((ext_vector_type(16))) float;
using u32x4  = __attribute__((ext_vector_type(4))) unsigned;
using u32x2  = __attribute__((ext_vector_type(2))) unsigned;
constexpr int CH = 128;
constexpr int NCH = SEQ / CH;
constexpr int VSTR = 576, KSTR = 320;
constexpr int L_V = 0, L_K = 73728, L_TOT = 114688, L_PRE = 116736, L_EB = 119296, L_SS = 119808, L_END = 120832;
constexpr float LOG2E = 1.4426950408889634f, LN2 = 0.6931471805599453f, DKS = 0.08838834764831845f;
__device__ __forceinline__ int crow(int r, int hi) { return (r & 3) + 8 * (r >> 2) + 4 * hi; }
typedef float f32x2_t __attribute__((ext_vector_type(2))); typedef __bf16 bf16x2_t __attribute__((ext_vector_type(2)));
__device__ __forceinline__ unsigned cvtpk(float lo, float hi) { f32x2_t v = {lo, hi}; bf16x2_t b = __builtin_convertvector(v, bf16x2_t); return __builtin_bit_cast(unsigned, b); }
__device__ __forceinline__ float bfround(float x) { return __builtin_bit_cast(float, cvtpk(x, 0.f) << 16); }
__device__ __forceinline__ s16x4 tr_read(int addr) { s16x4 r; asm volatile("ds_read_b64_tr_b16 %0, %1" : "=&v"(r) : "v"(addr) : "memory"); return r; }
#define GLA_LWAIT() do { asm volatile("s_waitcnt lgkmcnt(0)" ::: "memory"); __builtin_amdgcn_sched_barrier(0); } while (0)
template <int CTRL, int RMASK, bool BC> __device__ __forceinline__ float dpp_mov(float v) {
    return __builtin_bit_cast(float, __builtin_amdgcn_update_dpp(0, __builtin_bit_cast(int, v), CTRL, RMASK, 0xf, BC)); }
__device__ __forceinline__ float scan32(float v) {
    v += dpp_mov<0x111, 0xf, true>(v); v += dpp_mov<0x112, 0xf, true>(v); v += dpp_mov<0x114, 0xf, true>(v); v += dpp_mov<0x118, 0xf, true>(v);
    v += dpp_mov<0x142, 0xa, false>(v);
    return v;
}
__device__ __forceinline__ bf16x8 pack8(const float* v) { u32x4 w = {cvtpk(v[0], v[1]), cvtpk(v[2], v[3]), cvtpk(v[4], v[5]), cvtpk(v[6], v[7])}; return *reinterpret_cast<bf16x8*>(&w); }
#define GLA_PK(L, H) (bf16x8){L[0], L[1], L[2], L[3], H[0], H[1], H[2], H[3]}

struct Tensors { const bf16* GQ; const bf16* GK; const bf16* GV; const bf16* GR; const float* GLR; const float* WA; const float* BA; const float* GN; bf16* ST; float* DEC; bf16* OA; };

template <bool PASS_C>
__device__ __forceinline__ void unit(const Tensors& X, int b, int hh, int c, LAS unsigned char* lds) {
    const int tid = threadIdx.x, w = __builtin_amdgcn_readfirstlane(tid >> 6), lane = tid & 63, r = lane & 31, h = lane >> 5, pt = w & 3, dh = w >> 2;
    const size_t row0 = (size_t)b * SEQ + (size_t)c * CH, row = row0 + 32 * pt + r;
#pragma unroll
    for (int i = 0; i < 8; ++i) { const int piece = tid + 512 * i, ri = piece >> 5, cj = piece & 31;
        const u32x4 v = *reinterpret_cast<const u32x4*>(X.GV + (row0 + ri) * 1024 + hh * 256 + cj * 8);
        *reinterpret_cast<LAS u32x4*>(lds + L_V + ri * VSTR + cj * 16) = v; }
    constexpr int NT = PASS_C ? 4 : 2;
    const int T0 = PASS_C ? 0 : 2 * dh;
    float xb[NT][16];
    {
        const f32x4 g0 = *reinterpret_cast<const f32x4*>(X.GLR + row * 16 + 8 * h), g1 = *reinterpret_cast<const f32x4*>(X.GLR + row * 16 + 8 * h + 4);
        const float gv[8] = {g0.x, g0.y, g0.z, g0.w, g1.x, g1.y, g1.z, g1.w}; float gh[8], gl[8];
#pragma unroll
        for (int j = 0; j < 8; ++j) { gh[j] = bfround(gv[j]); gl[j] = gv[j] - gh[j]; }
        const bf16x8 Bhi = pack8(gh), Blo = pack8(gl);
#pragma unroll
        for (int t = 0; t < NT; ++t) { const int T = T0 + t;
            float wv[8], wh[8], wl[8];
#pragma unroll
            for (int j = 0; j < 8; ++j) { wv[j] = X.WA[(8 * h + j) * 512 + hh * 128 + 32 * T + r]; wh[j] = bfround(wv[j]); wl[j] = wv[j] - wh[j]; }
            const bf16x8 Ahi = pack8(wh), Alo = pack8(wl);
            f32x16 xt = {};
            xt = __builtin_amdgcn_mfma_f32_32x32x16_bf16(Ahi, Bhi, xt, 0, 0, 0);
            xt = __builtin_amdgcn_mfma_f32_32x32x16_bf16(Alo, Bhi, xt, 0, 0, 0);
            xt = __builtin_amdgcn_mfma_f32_32x32x16_bf16(Ahi, Blo, xt, 0, 0, 0);
#pragma unroll
            for (int g = 0; g < 4; ++g) { const f32x4 bb = *reinterpret_cast<const f32x4*>(X.BA + hh * 128 + 32 * T + 8 * g + 4 * h);
#pragma unroll
                for (int e = 0; e < 4; ++e) { const float xv = xt[4 * g + e] + bb[e];
                    const float ee = __builtin_amdgcn_exp2f(-fabsf(xv) * LOG2E); const float ls = fminf(xv, 0.f) - __builtin_amdgcn_logf(1.0f + ee) * LN2;
                    xb[t][4 * g + e] = scan32(ls * 0.0625f); } }
        }
    }
    LAS float* tot = (LAS float*)(lds + L_TOT); LAS float* pre = (LAS float*)(lds + L_PRE); LAS float* eB = (LAS float*)(lds + L_EB);
    if ((!PASS_C || dh == 0) && r == 31) {
#pragma unroll
        for (int t = 0; t < NT; ++t)
#pragma unroll
            for (int i = 0; i < 16; ++i) tot[pt * 128 + 32 * (T0 + t) + crow(i, h)] = xb[t][i];
    }
    __syncthreads();
    if (tid < 128) { float p = 0.f;
#pragma unroll
        for (int t = 0; t < 4; ++t) { pre[t * 128 + tid] = p; p += tot[t * 128 + tid]; }
        const float e = __builtin_amdgcn_exp2f(p * LOG2E); eB[tid] = e;
        if (!PASS_C) X.DEC[((size_t)(b * GLA_H + hh) * NCH + c) * 128 + tid] = e; }
    __syncthreads();
    bf16x8 qf[PASS_C ? 8 : 1];
#pragma unroll
    for (int t = 0; t < NT; ++t) { const int T = T0 + t; float kt[16], qt[16];
#pragma unroll
        for (int g = 0; g < 4; ++g) { const int ch0 = 32 * T + 8 * g + 4 * h;
            const f32x4 pp = *reinterpret_cast<const LAS f32x4*>(pre + pt * 128 + ch0);
            const u32x2 kw = *reinterpret_cast<const u32x2*>(X.GK + row * 512 + hh * 128 + ch0);
            const float kv[4] = {pg8::bf_lo(kw.x), pg8::bf_hi(kw.x), pg8::bf_lo(kw.y), pg8::bf_hi(kw.y)};
            float qv[4] = {0.f, 0.f, 0.f, 0.f};
            if (PASS_C) { const u32x2 qw = *reinterpret_cast<const u32x2*>(X.GQ + row * 512 + hh * 128 + ch0); qv[0] = pg8::bf_lo(qw.x); qv[1] = pg8::bf_hi(qw.x); qv[2] = pg8::bf_lo(qw.y); qv[3] = pg8::bf_hi(qw.y); }
#pragma unroll
            for (int e = 0; e < 4; ++e) { const float bb = (xb[t][4 * g + e] + pp[e]) * LOG2E;
                kt[4 * g + e] = kv[e] * __builtin_amdgcn_exp2f(-bb);
                if (PASS_C) qt[4 * g + e] = qv[e] * __builtin_amdgcn_exp2f(bb) * DKS; }
            if (!PASS_C) { u32x2 o; o.x = cvtpk(kt[4 * g], kt[4 * g + 1]); o.y = cvtpk(kt[4 * g + 2], kt[4 * g + 3]);
                *reinterpret_cast<LAS u32x2*>(lds + L_K + (32 * pt + r) * KSTR + ch0 * 2) = o; }
        }
        if (PASS_C) {
            qf[2 * t] = pack8(qt); qf[2 * t + 1] = pack8(qt + 8);
            if (dh == 0) { *reinterpret_cast<LAS bf16x8*>(lds + L_K + ((pt * 8 + 2 * T) * 64 + lane) * 16) = pack8(kt);
                           *reinterpret_cast<LAS bf16x8*>(lds + L_K + ((pt * 8 + 2 * T + 1) * 64 + lane) * 16) = pack8(kt + 8); }
        }
    }
    __syncthreads();
    const int q4 = (lane & 15) >> 2, p4 = lane & 3, rhalf = (lane >> 4) & 1;
    if constexpr (!PASS_C) {
        const int d = w;
        f32x16 acc[4] = {};
        const int vbase = (int)(uintptr_t)(lds + L_V) + (8 * h + q4) * VSTR + (32 * d + 16 * rhalf + 4 * p4) * 2;
        const int kbase = (int)(uintptr_t)(lds + L_K) + (8 * h + q4) * KSTR + (16 * rhalf + 4 * p4) * 2;
#pragma unroll 2
        for (int s = 0; s < 8; ++s) {
            const s16x4 v0 = tr_read(vbase + (16 * s) * VSTR), v1 = tr_read(vbase + (16 * s + 4) * VSTR);
            s16x4 k0[4], k1[4];
#pragma unroll
            for (int T = 0; T < 4; ++T) { k0[T] = tr_read(kbase + (16 * s) * KSTR + 64 * T); k1[T] = tr_read(kbase + (16 * s + 4) * KSTR + 64 * T); }
            GLA_LWAIT();
            const bf16x8 Bv = GLA_PK(v0, v1);
#pragma unroll
            for (int T = 0; T < 4; ++T) acc[T] = __builtin_amdgcn_mfma_f32_32x32x16_bf16(GLA_PK(k0[T], k1[T]), Bv, acc[T], 0, 0, 0);
        }
        unsigned char* Lg = (unsigned char*)X.ST + ((size_t)(b * GLA_H + hh) * NCH + c) * 65536;
#pragma unroll
        for (int T = 0; T < 4; ++T) { float o[16];
#pragma unroll
            for (int g = 0; g < 4; ++g) { const f32x4 sc = *reinterpret_cast<const LAS f32x4*>(eB + 32 * T + 8 * g + 4 * h);
#pragma unroll
                for (int e = 0; e < 4; ++e) o[4 * g + e] = acc[T][4 * g + e] * sc[e]; }
            *reinterpret_cast<bf16x8*>(Lg + (((d * 4 + T) * 2 + 0) * 64 + lane) * 16) = pack8(o);
            *reinterpret_cast<bf16x8*>(Lg + (((d * 4 + T) * 2 + 1) * 64 + lane) * 16) = pack8(o + 8); }
    } else {
        f32x16 acc[4] = {};
        const unsigned char* Sg = (const unsigned char*)X.ST + ((size_t)(b * GLA_H + hh) * NCH + c) * 65536;
#pragma unroll
        for (int dd = 0; dd < 4; ++dd) { const int d = 4 * dh + dd;
#pragma unroll
            for (int s = 0; s < 8; ++s) { const bf16x8 a = *reinterpret_cast<const bf16x8*>(Sg + ((d * 8 + s) * 64 + lane) * 16);
                acc[dd] = __builtin_amdgcn_mfma_f32_32x32x16_bf16(a, qf[s], acc[dd], 0, 0, 0); } }
        const int vbase = (int)(uintptr_t)(lds + L_V) + (4 * h + q4) * VSTR + (128 * dh + 16 * rhalf + 4 * p4) * 2;
        for (int t2 = 0; t2 <= pt; ++t2) {
            f32x16 st = {};
#pragma unroll
            for (int s = 0; s < 8; ++s) { const bf16x8 a = *reinterpret_cast<const LAS bf16x8*>(lds + L_K + ((t2 * 8 + s) * 64 + lane) * 16);
                st = __builtin_amdgcn_mfma_f32_32x32x16_bf16(a, qf[s], st, 0, 0, 0); }
            if (t2 == pt) {
#pragma unroll
                for (int i = 0; i < 16; ++i) if (crow(i, h) > r) st[i] = 0.f; }
            float sv[16];
#pragma unroll
            for (int i = 0; i < 16; ++i) sv[i] = st[i];
            const bf16x8 P0 = pack8(sv), P1 = pack8(sv + 8);
#pragma unroll
            for (int dd = 0; dd < 4; ++dd) {
                const int vb = vbase + (32 * t2) * VSTR + 64 * dd;
                const s16x4 a0 = tr_read(vb), a1 = tr_read(vb + 8 * VSTR), a2 = tr_read(vb + 16 * VSTR), a3 = tr_read(vb + 24 * VSTR);
                GLA_LWAIT();
                acc[dd] = __builtin_amdgcn_mfma_f32_32x32x16_bf16(GLA_PK(a0, a1), P0, acc[dd], 0, 0, 0);
                acc[dd] = __builtin_amdgcn_mfma_f32_32x32x16_bf16(GLA_PK(a2, a3), P1, acc[dd], 0, 0, 0);
            }
        }
        float ss = 0.f;
#pragma unroll
        for (int dd = 0; dd < 4; ++dd)
#pragma unroll
            for (int i = 0; i < 16; ++i) ss += acc[dd][i] * acc[dd][i];
        ss += __shfl_xor(ss, 32);
        LAS float* SS = (LAS float*)(lds + L_SS);
        if (h == 0) SS[(pt * 2 + dh) * 32 + r] = ss;
        __syncthreads();
        const float rs = 1.0f / sqrtf((SS[(pt * 2) * 32 + r] + SS[(pt * 2 + 1) * 32 + r]) * (1.0f / 256.0f) + NORM_EPS);
#pragma unroll
        for (int dd = 0; dd < 4; ++dd)
#pragma unroll
            for (int g = 0; g < 4; ++g) { const int dv = 128 * dh + 32 * dd + 8 * g + 4 * h;
                const f32x4 gn = *reinterpret_cast<const f32x4*>(X.GN + dv);
                const u32x2 gr = *reinterpret_cast<const u32x2*>(X.GR + row * 1024 + hh * 256 + dv);
                const float o0 = acc[dd][4 * g] * rs * gn.x * pg8::bf_lo(gr.x), o1 = acc[dd][4 * g + 1] * rs * gn.y * pg8::bf_hi(gr.x);
                const float o2 = acc[dd][4 * g + 2] * rs * gn.z * pg8::bf_lo(gr.y), o3 = acc[dd][4 * g + 3] * rs * gn.w * pg8::bf_hi(gr.y);
                u32x2 o; o.x = cvtpk(o0, o1); o.y = cvtpk(o2, o3);
                *reinterpret_cast<u32x2*>(X.OA + row * 1024 + hh * 256 + dv) = o; }
    }
    __syncthreads();
}
}

template <bool PASS_C>
__device__ __forceinline__ void gla_pass(Frame& F, const gla::Tensors& X) {
    for (int u = F.vcu; u < BATCH * GLA_H * gla::NCH; u += F.G) gla::unit<PASS_C>(X, u >> 8, (u >> 6) & 3, u & 63, F.lds + RING_OFF);
}
__device__ __forceinline__ void gla_scan(Frame& F, const gla::Tensors& X) {
    using gla::u32x2;
    const int gt = F.vcu * (NWAVES * 64) + F.tid;
    for (int e = gt; e < BATCH * GLA_H * 8192; e += F.G * NWAVES * 64) {
        const int bh = e >> 13, hp = e & 8191, piece = hp >> 1, j4 = hp & 1, lane = piece & 63, pu = piece >> 6, u = pu & 1, T = (pu >> 1) & 3;
        const int ch0 = 32 * T + 16 * u + 4 * (lane >> 5) + 8 * j4;
        unsigned char* base = (unsigned char*)X.ST + (size_t)bh * gla::NCH * 65536 + (size_t)piece * 16 + j4 * 8;
        const float* dec = X.DEC + (size_t)bh * gla::NCH * 128 + ch0;
        float s0 = 0.f, s1 = 0.f, s2 = 0.f, s3 = 0.f;
#pragma unroll 8
        for (int c = 0; c < gla::NCH; ++c) {
            const u32x2 l = *reinterpret_cast<const u32x2*>(base + (size_t)c * 65536);
            const f32x4 dc = *reinterpret_cast<const f32x4*>(dec + c * 128);
            u32x2 o; o.x = gla::cvtpk(s0, s1); o.y = gla::cvtpk(s2, s3);
            *reinterpret_cast<u32x2*>(base + (size_t)c * 65536) = o;
            s0 = fmaf(dc.x, s0, pg8::bf_lo(l.x)); s1 = fmaf(dc.y, s1, pg8::bf_hi(l.x)); s2 = fmaf(dc.z, s2, pg8::bf_lo(l.y)); s3 = fmaf(dc.w, s3, pg8::bf_hi(l.y));
        }
    }
}

namespace moba {
using bf16x8 = __attribute__((ext_vector_type(8))) short;
using s16x4  = __attribute__((ext_vector_type(4))) short;
using f32x16 = __attribute__((ext_vector_type(16))) float;
using u32x4  = __attribute__((ext_vector_type(4))) unsigned;
constexpr int D = 128, NW = 8, QBLK = 32, KVBLK = 64, LDQ = 1024, LDK = 1024, LDO = 1024;
constexpr float SCALE = 0.088388347648318440f, LOG2E = 1.4426950408889634f, C = SCALE * LOG2E;
constexpr int SDEPTH = 1;
constexpr float THRL = 8.f * LOG2E;
constexpr size_t SHM_V = KVBLK * D * 2, SHM_K = KVBLK * D * 2, SHM_Q = 2 * SHM_V + 2 * SHM_K + NW * 64 * 4, SHM_ATTN = SHM_Q + 65536;
#define KSWZ(row, colB) ((row) * 256 + ((colB) ^ (((row) & 7) << 4)))
#define SBAR() __builtin_amdgcn_sched_barrier(0)
__device__ __forceinline__ int crow(int r, int hi) { return (r & 3) + 8 * (r >> 2) + 4 * hi; }
__device__ __forceinline__ unsigned cvtpk(float lo, float hi) { unsigned r; asm volatile("v_cvt_pk_bf16_f32 %0, %1, %2" : "=v"(r) : "v"(lo), "v"(hi)); return r; }

template <bool CAUSAL>
__device__ __forceinline__ void partialSM(f32x16& p0, f32x16& p1, float& m_reg, float& mn, float& alpha, float lanebase, float sl2, int dk) {
#pragma unroll
  for (int r = 0; r < 16; ++r) { const int cr = (r & 3) + 8 * (r >> 2);
    p0[r] = fmaf(p0[r], C, fmaf(sl2, (float)cr, lanebase)); p1[r] = fmaf(p1[r], C, fmaf(sl2, (float)(cr + 32), lanebase));
    if (CAUSAL) { if (cr + dk > 0) p0[r] = -INFINITY; if (cr + 32 + dk > 0) p1[r] = -INFINITY; } }
  float pmax = p0[0];
#pragma unroll
  for (int r = 1; r < 16; ++r) pmax = fmaxf(pmax, p0[r]);
#pragma unroll
  for (int r = 0; r < 16; ++r) pmax = fmaxf(pmax, p1[r]);
  { auto rr = __builtin_amdgcn_permlane32_swap(__float_as_uint(pmax), __float_as_uint(pmax), false, false);
    pmax = fmaxf(__uint_as_float(rr[0]), __uint_as_float(rr[1])); }
  if (__builtin_expect(__all(pmax - m_reg <= THRL), 1)) { mn = m_reg; alpha = 1.f; }
  else { mn = fmaxf(m_reg, pmax); alpha = __builtin_amdgcn_exp2f(m_reg - mn); m_reg = mn; }
#pragma unroll
  for (int r = 0; r < 16; ++r) { p0[r] = __builtin_amdgcn_exp2f(p0[r] - mn); p1[r] = p1[r] - mn; }
}
__device__ __forceinline__ void finishSM(f32x16& p0, f32x16& p1, float alpha, float& l_reg, bf16x8& pa0, bf16x8& pa1, bf16x8& pa2, bf16x8& pa3) {
#pragma unroll
  for (int r = 0; r < 16; ++r) p1[r] = __builtin_amdgcn_exp2f(p1[r]);
  float ps = 0;
#pragma unroll
  for (int r = 0; r < 16; ++r) ps += p0[r];
#pragma unroll
  for (int r = 0; r < 16; ++r) ps += p1[r];
  { auto rr = __builtin_amdgcn_permlane32_swap(__float_as_uint(ps), __float_as_uint(ps), false, false);
    ps = __uint_as_float(rr[0]) + __uint_as_float(rr[1]); }
  l_reg = l_reg * alpha + ps;
#define PK4(P, BASE, OUT) do { unsigned a0 = cvtpk(P[BASE + 0], P[BASE + 1]), a1 = cvtpk(P[BASE + 2], P[BASE + 3]);   \
    unsigned b0 = cvtpk(P[BASE + 4], P[BASE + 5]), b1 = cvtpk(P[BASE + 6], P[BASE + 7]);                              \
    auto r0 = __builtin_amdgcn_permlane32_swap(a0, b0, false, false); auto r1 = __builtin_amdgcn_permlane32_swap(a1, b1, false, false); \
    u32x4 w = {r0[0], r1[0], r0[1], r1[1]}; OUT = *reinterpret_cast<bf16x8*>(&w); } while (0)
  PK4(p0, 0, pa0); PK4(p0, 8, pa1); PK4(p1, 0, pa2); PK4(p1, 8, pa3);
#undef PK4
}
__device__ __forceinline__ void qkt(f32x16& p0, f32x16& p1, const LAS unsigned char* Ks, const LAS unsigned char* qf, int r32, int hi) {
  p0 = f32x16{}; p1 = f32x16{};
#pragma unroll
  for (int d0 = 0; d0 < 8; ++d0) { int cb = (d0 * 16 + hi * 8) * 2;
    bf16x8 b0 = *reinterpret_cast<const LAS bf16x8*>(Ks + KSWZ(r32, cb));
    bf16x8 b1 = *reinterpret_cast<const LAS bf16x8*>(Ks + KSWZ(32 + r32, cb));
    bf16x8 q = *reinterpret_cast<const LAS bf16x8*>(qf + d0 * 1024);
    p0 = __builtin_amdgcn_mfma_f32_32x32x16_bf16(b0, q, p0, 0, 0, 0);
    p1 = __builtin_amdgcn_mfma_f32_32x32x16_bf16(b1, q, p1, 0, 0, 0); }
}
__device__ __forceinline__ int v_st(int k, int c) { const int kk = (k & ~0xC) | ((k & 4) << 1) | ((k & 8) >> 1); return ((kk >> 3) * 4 + (c >> 5)) * 512 + ((kk & 7) * 32 + (c & 31)) * 2; }
__device__ __forceinline__ int v_rd_base(int lane) { return ((lane & 3) << 3) | (((lane >> 2) & 3) << 6) | (((lane >> 4) & 1) << 5) | (((lane >> 5) & 1) << 8); }
constexpr int v_rd_off(int d0, int ks, int half) { return d0 * 512 + ks * 4096 + half * 2048; }
template <int OFF> __device__ __forceinline__ s16x4 tr_read(int vb) {
  s16x4 r; asm volatile("ds_read_b64_tr_b16 %0, %1 offset:%2" : "=&v"(r) : "v"(vb), "i"(OFF) : "memory"); return r;
}
template <int D0> __device__ __forceinline__ void pv_one(f32x16& od, int vb, bf16x8 pa0, bf16x8 pa1, bf16x8 pa2, bf16x8 pa3) {
  const s16x4 l0 = tr_read<v_rd_off(D0, 0, 0)>(vb), h0 = tr_read<v_rd_off(D0, 0, 1)>(vb), l1 = tr_read<v_rd_off(D0, 1, 0)>(vb), h1 = tr_read<v_rd_off(D0, 1, 1)>(vb);
  const s16x4 l2 = tr_read<v_rd_off(D0, 2, 0)>(vb), h2 = tr_read<v_rd_off(D0, 2, 1)>(vb), l3 = tr_read<v_rd_off(D0, 3, 0)>(vb), h3 = tr_read<v_rd_off(D0, 3, 1)>(vb);
  asm volatile("s_waitcnt lgkmcnt(0)" ::: "memory"); SBAR();
#define PK(L, H) (bf16x8){L[0], L[1], L[2], L[3], H[0], H[1], H[2], H[3]}
  od = __builtin_amdgcn_mfma_f32_32x32x16_bf16(pa0, PK(l0, h0), od, 0, 0, 0);
  od = __builtin_amdgcn_mfma_f32_32x32x16_bf16(pa1, PK(l1, h1), od, 0, 0, 0);
  od = __builtin_amdgcn_mfma_f32_32x32x16_bf16(pa2, PK(l2, h2), od, 0, 0, 0);
  od = __builtin_amdgcn_mfma_f32_32x32x16_bf16(pa3, PK(l3, h3), od, 0, 0, 0);
#undef PK
}
__device__ __forceinline__ void pv_d0(f32x16* o, int vb, bf16x8 pa0, bf16x8 pa1, bf16x8 pa2, bf16x8 pa3) {
  pv_one<0>(o[0], vb, pa0, pa1, pa2, pa3); pv_one<1>(o[1], vb, pa0, pa1, pa2, pa3); pv_one<2>(o[2], vb, pa0, pa1, pa2, pa3); pv_one<3>(o[3], vb, pa0, pa1, pa2, pa3);
}

__device__ __forceinline__ void unit(const bf16* __restrict__ Qb, const bf16* __restrict__ Kh, const bf16* __restrict__ Vh, bf16* __restrict__ Ob,
                                     const unsigned* __restrict__ selrow, int qi, float sl2, LAS unsigned char* lds) {
  const int tid = threadIdx.x, wid = tid >> 6, lane = tid & 63, r32 = lane & 31, hi = lane >> 5;
  LAS unsigned char* V_lds = lds; LAS unsigned char* K_lds = lds + 2 * SHM_V;
  LAS float* ws = (LAS float*)(lds + 2 * SHM_V + 2 * SHM_K) + wid * 64; LAS float* li_l = ws; LAS float* al_l = ws + 32;
  float m_reg = -1e30f, l_reg = 0; f32x16 o[4] = {};
  LAS unsigned char* qr = lds + SHM_Q + wid * 8192 + lane * 16;
  const int qrel = wid * QBLK + r32, tq = qi * 256 + qrel;
  const unsigned selm = selrow[qrel];
  const bf16* Qw = Qb + (long)qrel * LDQ + hi * 8;
#pragma unroll
  for (int d0 = 0; d0 < 8; ++d0) *reinterpret_cast<LAS bf16x8*>(qr + d0 * 1024) = *reinterpret_cast<const bf16x8*>(Qw + d0 * 16);
  const int sr = tid >> 4, sc = (tid & 15) * 8, vst0 = v_st(sr, sc), vst1 = v_st(32 + sr, sc);
  const int vb0 = (int)(uintptr_t)V_lds + v_rd_base(lane);
  struct { bf16x8 vs0, vs1, ks0, ks1; } sr_[SDEPTH];
  const int NT = 4 * (qi + 1);
#define KT(t) ((t) < 4 ? 4 * qi + (t) : (t) - 4)
#define SLOAD(i, t) do { const int k0_ = KT(t) * KVBLK; sr_[i].vs0 = *reinterpret_cast<const bf16x8*>(&Vh[(long)(k0_ + sr) * LDK + sc]); sr_[i].vs1 = *reinterpret_cast<const bf16x8*>(&Vh[(long)(k0_ + 32 + sr) * LDK + sc]); \
    sr_[i].ks0 = *reinterpret_cast<const bf16x8*>(&Kh[(long)(k0_ + sr) * LDK + sc]); sr_[i].ks1 = *reinterpret_cast<const bf16x8*>(&Kh[(long)(k0_ + 32 + sr) * LDK + sc]); } while (0)
#define SWRITE(b, i) do { *(LAS bf16x8*)(V_lds + (b) * SHM_V + vst0) = sr_[i].vs0;          \
    *(LAS bf16x8*)(V_lds + (b) * SHM_V + vst1) = sr_[i].vs1; int kc = sc * 2;               \
    *(LAS bf16x8*)(K_lds + (b) * SHM_K + KSWZ(sr, kc)) = sr_[i].ks0;                       \
    *(LAS bf16x8*)(K_lds + (b) * SHM_K + KSWZ(32 + sr, kc)) = sr_[i].ks1; } while (0)
#define SWAIT() do { if (SDEPTH == 2) asm volatile("s_waitcnt vmcnt(4)" ::: "memory"); else asm volatile("s_waitcnt vmcnt(0)" ::: "memory"); } while (0)
#define RESC(a) do { if (__any((a) < 1.f)) { if (hi == 0) al_l[r32] = (a); asm volatile("s_waitcnt lgkmcnt(0)" ::: "memory"); \
    _Pragma("unroll") for (int d = 0; d < 4; ++d) _Pragma("unroll") for (int r = 0; r < 16; ++r) o[d][r] *= al_l[crow(r, hi)]; } } while (0)
#define PSM(P0, P1, MN, AL, t) do { const int kt_ = KT(t), dk_ = kt_ * KVBLK + 4 * hi - tq; \
    if ((t) < 4) partialSM<true>(P0, P1, m_reg, MN, AL, sl2 * (float)dk_, sl2, dk_); \
    else { const float lb_ = ((selm >> (kt_ >> 2)) & 1u) ? sl2 * (float)dk_ : -INFINITY; partialSM<false>(P0, P1, m_reg, MN, AL, lb_, sl2, dk_); } } while (0)
  f32x16 pA0, pA1, pB0, pB1; float mnA, mnB, alA, alB; bf16x8 pa0, pa1, pa2, pa3;
  constexpr int SE = 0, SO = SDEPTH - 1;
  SLOAD(SE, 0); asm volatile("s_waitcnt vmcnt(0)" ::: "memory"); SWRITE(0, SE); __syncthreads();
  qkt(pA0, pA1, K_lds, qr, r32, hi); PSM(pA0, pA1, mnA, alA, 0);
  SLOAD(SO, 1); if (SDEPTH == 2) { if (2 < NT) SLOAD(SE, 2); }
  SWAIT(); SWRITE(1, SO); __syncthreads();
  for (int j = 1; j + 1 < NT; j += 2) {
    SBAR(); qkt(pB0, pB1, K_lds + SHM_K, qr, r32, hi);
    finishSM(pA0, pA1, alA, l_reg, pa0, pa1, pa2, pa3); SBAR();
    SLOAD(SO, j + SDEPTH); SBAR();
    pv_d0(o, vb0, pa0, pa1, pa2, pa3); PSM(pB0, pB1, mnB, alB, j);
    __syncthreads(); SWAIT(); SWRITE(0, SE);
    RESC(alB); __syncthreads();
    SBAR(); qkt(pA0, pA1, K_lds, qr, r32, hi);
    finishSM(pB0, pB1, alB, l_reg, pa0, pa1, pa2, pa3); SBAR();
    if (SDEPTH == 1 || j + 3 < NT) SLOAD(SE, j + 1 + SDEPTH); SBAR();
    pv_d0(o, vb0 + (int)SHM_V, pa0, pa1, pa2, pa3); PSM(pA0, pA1, mnA, alA, j + 1);
    __syncthreads(); SWAIT(); SWRITE(1, SO);
    RESC(alA); __syncthreads();
  }
  SBAR(); qkt(pB0, pB1, K_lds + SHM_K, qr, r32, hi);
  finishSM(pA0, pA1, alA, l_reg, pa0, pa1, pa2, pa3); SBAR();
  pv_d0(o, vb0, pa0, pa1, pa2, pa3); PSM(pB0, pB1, mnB, alB, NT - 1);
  __syncthreads(); RESC(alB);
  finishSM(pB0, pB1, alB, l_reg, pa0, pa1, pa2, pa3); SBAR();
  pv_d0(o, vb0 + (int)SHM_V, pa0, pa1, pa2, pa3);
  if (hi == 0) li_l[r32] = l_reg; asm volatile("s_waitcnt lgkmcnt(0)" ::: "memory");
  float rli[16];
#pragma unroll
  for (int r = 0; r < 16; ++r) rli[r] = __builtin_amdgcn_rcpf(li_l[crow(r, hi)]);
  bf16* Ow = Ob + (long)(wid * QBLK) * LDO;
#pragma unroll
  for (int r = 0; r < 16; ++r) { int orow = crow(r, hi);
#pragma unroll
    for (int d0 = 0; d0 < 4; ++d0) Ow[(long)orow * LDO + d0 * 32 + r32] = (bf16)f2bf(o[d0][r] * rli[r]); }
  __syncthreads();
#undef KT
#undef SLOAD
#undef SWRITE
#undef SWAIT
#undef RESC
#undef PSM
}
#undef KSWZ
#undef SBAR
}

__device__ __forceinline__ void moba_kmean_phase(Frame& F, const bf16* MK, float* kmean) {
    LAS float* red = (LAS float*)(F.lds + RING_OFF);
    for (int u = F.vcu; u < BATCH * MOBA_NB * 2; u += F.G) {
        const int half = u & 1, bj = u >> 1;
        const int cp = F.tid & 255, rh = F.tid >> 8;
        const unsigned* src = (const unsigned*)(MK + (size_t)(bj * 256 + rh * 128) * 1024 + half * 512) + cp;
        float s0 = 0.f, s1 = 0.f;
#pragma unroll 8
        for (int r = 0; r < 128; ++r) { const unsigned w = src[(size_t)r * 512]; s0 += pg8::bf_lo(w); s1 += pg8::bf_hi(w); }
        if (rh == 1) { red[cp * 2] = s0; red[cp * 2 + 1] = s1; }
        __syncthreads();
        if (rh == 0) { float* dst = kmean + (size_t)bj * 1024 + half * 512 + cp * 2; dst[0] = (s0 + red[cp * 2]) * (1.0f / 256.0f); dst[1] = (s1 + red[cp * 2 + 1]) * (1.0f / 256.0f); }
        __syncthreads();
    }
}
__device__ __forceinline__ void moba_select_phase(Frame& F, const bf16* MQ, const float* kmean, unsigned* sel) {
    LAS float* km = (LAS float*)(F.lds + RING_OFF);
    for (int u = F.vcu; u < BATCH * MOBA_NB * MOBA_H; u += F.G) {
        const int h = u & 7, qi = (u >> 3) & 31, b = u >> 8;
        const int q = F.tid >> 1, half = F.tid & 1;
        unsigned mask = 0u;
        if (qi > 0) {
            for (int e = F.tid; e < qi * 128; e += NWAVES * 64) km[e] = kmean[(size_t)(b * 32 + (e >> 7)) * 1024 + h * 128 + (e & 127)];
            const pg8::u32x4* qp = (const pg8::u32x4*)(MQ + (size_t)(b * SEQ + qi * 256 + q) * 1024 + h * 128 + half * 64);
            float qv[64];
#pragma unroll
            for (int i = 0; i < 8; ++i) { const pg8::u32x4 w = qp[i]; qv[8 * i] = pg8::bf_lo(w.x); qv[8 * i + 1] = pg8::bf_hi(w.x); qv[8 * i + 2] = pg8::bf_lo(w.y); qv[8 * i + 3] = pg8::bf_hi(w.y);
                qv[8 * i + 4] = pg8::bf_lo(w.z); qv[8 * i + 5] = pg8::bf_hi(w.z); qv[8 * i + 6] = pg8::bf_lo(w.w); qv[8 * i + 7] = pg8::bf_hi(w.w); }
            __syncthreads();
            float v0 = -INFINITY, v1 = -INFINITY, v2 = -INFINITY; int i0 = -1, i1 = -1, i2 = -1;
            for (int j = 0; j < qi; ++j) {
                const LAS f32x4* kr = (const LAS f32x4*)(km + j * 128 + half * 64);
                float s = 0.f;
#pragma unroll
                for (int i = 0; i < 16; ++i) { const f32x4 k4 = kr[i]; s = fmaf(qv[4 * i], k4.x, s); s = fmaf(qv[4 * i + 1], k4.y, s); s = fmaf(qv[4 * i + 2], k4.z, s); s = fmaf(qv[4 * i + 3], k4.w, s); }
                s += __shfl_xor(s, 1);
                if (s > v0) { v2 = v1; i2 = i1; v1 = v0; i1 = i0; v0 = s; i0 = j; }
                else if (s > v1) { v2 = v1; i2 = i1; v1 = s; i1 = j; }
                else if (s > v2) { v2 = s; i2 = j; }
            }
            if (i0 >= 0) mask |= 1u << i0; if (i1 >= 0) mask |= 1u << i1; if (i2 >= 0) mask |= 1u << i2;
        }
        if (half == 0) sel[(size_t)(b * MOBA_H + h) * SEQ + qi * 256 + q] = mask;
        __syncthreads();
    }
}
__device__ __forceinline__ void moba_attn_phase(Frame& F, const bf16* MQ, const bf16* MK, const bf16* MV, bf16* OB, const unsigned* sel) {
    const int c = (int)blockIdx.x, bh = c & 31, g = (c >> 5) & 7, b = bh >> 3, h = bh & 7;
    const float sl2 = __builtin_amdgcn_exp2f(-(float)(h + 1)) * moba::LOG2E;
    if (F.G != 256) return;
    for (int k = 0; k < 4; ++k) {
        const int qi = (k == 0) ? g : (k == 1) ? 15 - g : (k == 2) ? 16 + g : 31 - g;
        const size_t qrow = (size_t)b * SEQ + (size_t)qi * 256;
        moba::unit(MQ + qrow * 1024 + h * 128, MK + (size_t)b * SEQ * 1024 + h * 128, MV + (size_t)b * SEQ * 1024 + h * 128, OB + qrow * 1024 + h * 128,
                   sel + (size_t)(b * MOBA_H + h) * SEQ + qi * 256, qi, sl2, F.lds + RING_OFF);
    }
}

struct Args { const float* in[18]; float* out; unsigned char* ws; int ph_lo, ph_hi, li, pad; };
enum { I_X = 0, I_N1, I_WG1, I_WU1, I_WD1, I_NMIX, I_WIN, I_WALPHA, I_BALPHA, I_GONORM, I_WBG, I_WBM, I_WOUT, I_N2, I_WG2, I_WU2, I_WD2, I_NF };

__global__ void __launch_bounds__(NWAVES * 64, 2) mk_fwd(Args args) {
    extern __shared__ __attribute__((aligned(16))) unsigned char lds[];
    Frame F;
    F.lds = (LAS unsigned char*)lds;
    F.MISC = (volatile LAS unsigned*)(F.lds + MISC_OFF);
    F.tid = threadIdx.x; F.lane = F.tid & 63; F.wave = __builtin_amdgcn_readfirstlane(F.tid >> 6);
    F.G = gridDim.x; { const int bx = blockIdx.x; F.vcu = (F.G % 8 == 0) ? (bx % 8) * (F.G / 8) + bx / 8 : bx; }
    unsigned char* ws = args.ws;
    F.ctl = (gu32*)(ws + WS_CTL);
    for (int u = F.tid; u < (LDS_BYTES - LDSCTL_OFF) / 4; u += NWAVES * 64) ((LAS unsigned*)(F.lds + LDSCTL_OFF))[u] = 0u;
    __syncthreads();
    XcdBarrier bar; bar.bar = (unsigned*)(F.ctl + CW_BAR); bar.x = 0; bar.st = nullptr;
    if (!MK_PER_PHASE) bar = xcd_barrier_post((unsigned*)(F.ctl + CW_BAR), F.MISC + 8);
#define GRID_BAR() do { if (!MK_PER_PHASE) xcd_barrier(bar); } while (0)
    const int lo = args.ph_lo, hi = args.ph_hi;
#define IN(k) (lo <= (k) && (k) < hi)
#define BOTH(k) (IN(k) && IN((k) + 1))
    const float* x = args.in[I_X]; float* out = args.out;
    bf16* WGU = (bf16*)(ws + WS_WGU); bf16* WD = (bf16*)(ws + WS_WD); bf16* WIN = (bf16*)(ws + WS_WIN); bf16* WBG = (bf16*)(ws + WS_WBG); bf16* WBM = (bf16*)(ws + WS_WBM); bf16* WO = (bf16*)(ws + WS_WO);
    bf16* XN = (bf16*)(ws + WS_XN); bf16* HID = (bf16*)(ws + WS_R1); unsigned char* R1 = ws + WS_R1;
    bf16* OA = XN; bf16* OB = XN + (size_t)M * 1024; bf16* YM = (bf16*)(R1 + R1_GQ);

    if (IN(0)) {
        int cur = 0;
        transpose_weight(F, args.in[I_WG1], DM, DFF, WGU, MapGU{0}, cur);
        transpose_weight(F, args.in[I_WU1], DM, DFF, WGU, MapGU{1}, cur);
        transpose_weight(F, args.in[I_WD1], DFF, DM, WD, MapId{}, cur);
        transpose_weight(F, args.in[I_WIN], DM, D_IN, WIN, MapIn{}, cur);
        transpose_weight(F, args.in[I_WBG], 1024, DM, WBG, MapId{}, cur);
        transpose_weight(F, args.in[I_WBM], 1024, DM, WBM, MapId{}, cur);
        transpose_weight(F, args.in[I_WOUT], DM, DM, WO, MapId{}, cur);
        zero_rows_bf16(F, WIN + (size_t)D_IN * DM, (size_t)(NPROJ - D_IN) * DM * 2);
        rms_rows_bf16(F, x, args.in[I_N1], XN);
        if (BOTH(0)) GRID_BAR();
    }
    if (IN(1)) {
        pg8::Gemm g{XN, WGU, M, 2 * DFF, DM}; pg8::StaticOrder S; S.init(M, 2 * DFF, F.G, (int)blockIdx.x);
        pg8::EpiSwiGLU E{HID, DFF};
        pg8::gemm_phase<pg8::EpiSwiGLU, pg8::StaticOrder, true, true>(F.lds + RING_OFF, g, S, E);
        if (BOTH(1)) GRID_BAR();
    }
    if (IN(2)) {
        pg8::Gemm g{HID, WD, M, DM, DFF}; pg8::StaticOrder S; S.init(M, DM, F.G, (int)blockIdx.x);
        pg8::EpiResid E{x, out, DM, 0.5f};
        pg8::gemm_phase<pg8::EpiResid, pg8::StaticOrder, true, true>(F.lds + RING_OFF, g, S, E);
        if (BOTH(2)) GRID_BAR();
    }
    if (IN(3)) {
        int cur = 0;
        transpose_weight(F, args.in[I_WG2], DM, DFF, WGU, MapGU{0}, cur);
        transpose_weight(F, args.in[I_WU2], DM, DFF, WGU, MapGU{1}, cur);
        transpose_weight(F, args.in[I_WD2], DFF, DM, WD, MapId{}, cur);
        rms_rows_bf16(F, out, args.in[I_NMIX], XN);
        if (BOTH(3)) GRID_BAR();
    }
    if (IN(4)) {
        pg8::Gemm g{XN, WIN, M, NPROJ, DM}; pg8::StaticOrder S; S.init(M, NPROJ, F.G, (int)blockIdx.x);
        pg8::EpiProj E{R1};
        pg8::gemm_phase<pg8::EpiProj, pg8::StaticOrder, true, true>(F.lds + RING_OFF, g, S, E);
        if (BOTH(4)) GRID_BAR();
    }
    const bf16* MQ = (const bf16*)(R1 + R1_MQ); const bf16* MKp = (const bf16*)(R1 + R1_MK); const bf16* MV = (const bf16*)(R1 + R1_MV);
    float* KMEAN = (float*)(ws + WS_MISC + MISC_KMEAN); unsigned* SEL = (unsigned*)(ws + WS_MISC + MISC_SEL);
    const gla::Tensors GX{(const bf16*)(R1 + R1_GQ), (const bf16*)(R1 + R1_GK), (const bf16*)(R1 + R1_GV), (const bf16*)(R1 + R1_GR), (const float*)(R1 + R1_GLR),
                          args.in[I_WALPHA], args.in[I_BALPHA], args.in[I_GONORM], (bf16*)(ws + WS_GLAS), (float*)(ws + WS_MISC + MISC_DEC), OA};
    if (IN(5)) {
#if MK_NO_GLA
        zero_rows_bf16(F, OA, (size_t)M * 1024 * 2);
#else
        gla_pass<false>(F, GX);
#endif
#if MK_NO_MOBA
        zero_rows_bf16(F, OB, (size_t)M * 1024 * 2);
#else
        moba_kmean_phase(F, MKp, KMEAN);
#endif
        if (BOTH(5)) GRID_BAR();
    }
    if (IN(6)) {
#if !MK_NO_GLA
        gla_scan(F, GX);
#endif
#if !MK_NO_MOBA
        moba_select_phase(F, MQ, KMEAN, SEL);
#endif
        if (BOTH(6)) GRID_BAR();
    }
    if (IN(7)) {
#if !MK_NO_GLA
        gla_pass<true>(F, GX);
#endif
#if !MK_NO_MOBA
        moba_attn_phase(F, MQ, MKp, MV, OB, SEL);
#endif
        if (BOTH(7)) GRID_BAR();
    }
    if (IN(8)) {
        { pg8::Gemm g{OA, WBG, M, DM, 1024}; pg8::StaticOrder S; S.init(M, DM, F.G, (int)blockIdx.x);
          pg8::EpiGateMul<false> E{(const bf16*)(R1 + R1_GA), YM, DM};
          pg8::gemm_phase<pg8::EpiGateMul<false>, pg8::StaticOrder, true, true>(F.lds + RING_OFF, g, S, E); }
        { pg8::Gemm g{OB, WBM, M, DM, 1024}; pg8::StaticOrder S; S.init(M, DM, F.G, (int)blockIdx.x);
          pg8::EpiGateMul<true> E{(const bf16*)(R1 + R1_GB), YM, DM};
          pg8::gemm_phase<pg8::EpiGateMul<true>, pg8::StaticOrder, true, true>(F.lds + RING_OFF, g, S, E); }
        if (BOTH(8)) GRID_BAR();
    }
    if (IN(9)) {
        pg8::Gemm g{YM, WO, M, DM, DM}; pg8::StaticOrder S; S.init(M, DM, F.G, (int)blockIdx.x);
        pg8::EpiResid E{out, out, DM, 1.0f};
        pg8::gemm_phase<pg8::EpiResid, pg8::StaticOrder, true, true>(F.lds + RING_OFF, g, S, E);
        if (BOTH(9)) GRID_BAR();
    }
    if (IN(10)) { rms_rows_bf16(F, out, args.in[I_N2], XN); if (BOTH(10)) GRID_BAR(); }
    if (IN(11)) {
        pg8::Gemm g{XN, WGU, M, 2 * DFF, DM}; pg8::StaticOrder S; S.init(M, 2 * DFF, F.G, (int)blockIdx.x);
        pg8::EpiSwiGLU E{HID, DFF};
        pg8::gemm_phase<pg8::EpiSwiGLU, pg8::StaticOrder, true, true>(F.lds + RING_OFF, g, S, E);
        if (BOTH(11)) GRID_BAR();
    }
    if (IN(12)) {
        pg8::Gemm g{HID, WD, M, DM, DFF}; pg8::StaticOrder S; S.init(M, DM, F.G, (int)blockIdx.x);
        pg8::EpiResid E{out, out, DM, 0.5f};
        pg8::gemm_phase<pg8::EpiResid, pg8::StaticOrder, true, true>(F.lds + RING_OFF, g, S, E);
        if (BOTH(12)) GRID_BAR();
    }
    if (IN(13)) { rms_rows_f32_inplace(F, out, args.in[I_NF]); }
#undef IN
#undef BOTH
}

extern "C" void kernel_launch(void* const* d_in, const int* in_sizes, int n_in, void* d_out, int out_size, void* d_ws, size_t ws_size, hipStream_t stream) {
    static int grid = 0;
    if (grid == 0) {
        if (n_in != 18 || in_sizes[0] != M * DM || out_size != M * DM || ws_size < WS_END) { fprintf(stderr, "kernel_launch: unexpected shapes (n_in %d, in0 %d, out %d, ws %zu < %zu)\n", n_in, n_in > 0 ? in_sizes[0] : -1, out_size, ws_size, (size_t)WS_END); grid = -1; return; }
        int dev = 0, cus = 0, per_cu = 0;
        if (hipGetDevice(&dev) != hipSuccess || hipDeviceGetAttribute(&cus, hipDeviceAttributeMultiprocessorCount, dev) != hipSuccess) { grid = -1; return; }
        if (hipFuncSetAttribute((const void*)mk_fwd, hipFuncAttributeMaxDynamicSharedMemorySize, LDS_BYTES) != hipSuccess) { fprintf(stderr, "kernel_launch: hipFuncSetAttribute failed\n"); grid = -1; return; }
        if (hipOccupancyMaxActiveBlocksPerMultiprocessor(&per_cu, (const void*)mk_fwd, NWAVES * 64, LDS_BYTES) != hipSuccess || per_cu < 1) { fprintf(stderr, "kernel_launch: occupancy query says %d\n", per_cu); }
        (void)hipGetLastError();
        grid = cus;
    }
    if (grid < 0) return;
    if (hipMemsetAsync((char*)d_ws + WS_CTL, 0, CTL_ZERO_BYTES, stream) != hipSuccess) return;
    Args a{};
    for (int i = 0; i < 18; ++i) a.in[i] = (const float*)d_in[i];
    a.out = (float*)d_out; a.ws = (unsigned char*)d_ws; a.pad = 0;
#if MK_PER_PHASE
    for (int p = 0; p < N_PHASES; ++p) { a.ph_lo = p; a.ph_hi = p + 1; a.li = p; hipLaunchKernelGGL(mk_fwd, dim3(grid), dim3(NWAVES * 64), LDS_BYTES, stream, a); }
#else
    a.ph_lo = 0; a.ph_hi = N_PHASES; a.li = 0;
    hipLaunchKernelGGL(mk_fwd, dim3(grid), dim3(NWAVES * 64), LDS_BYTES, stream, a);
#endif
    const hipError_t le = hipPeekAtLastError();
    if (le != hipSuccess) fprintf(stderr, "kernel_launch: launch failed: %s\n", hipGetErrorName(le));
}
```

```cpp
#include <hip/hip_runtime.h>
#include <cstdio>
#include <cstdint>
namespace pg8 {
#define PG8_LAS __attribute__((address_space(3)))
typedef unsigned short bf16_t;
typedef short bf16x8 __attribute__((ext_vector_type(8)));
typedef float f32x4 __attribute__((ext_vector_type(4)));
typedef unsigned u32x4 __attribute__((ext_vector_type(4)));
constexpr int BM = 256, BK = 64, HALF = 128, HTB = HALF * BK * 2  , STAGE_BYTES = 8 * HTB, NXCD = 8, WGM = 8;

__host__ __device__ __forceinline__ int lds_byte(int r, int c) { const int st = (r >> 4) * 2 + (c >> 5), rr = r & 15, cc = c & 31, ob = rr * 64 + cc * 2; return st * 1024 + (ob ^ (((ob >> 9) & 1) << 5)); }
__host__ __device__ __forceinline__ void stage_rc(int b, int& R, int& C) { const int st = b / 1024, sb = b % 1024, swz = sb ^ (((sb >> 9) & 1) << 5); R = (st >> 1) * 16 + swz / 64; C = (st & 1) * 32 + (swz % 64) / 2; }
__host__ __device__ __forceinline__ int perm32(int rho) { const int n = rho >> 4, i = rho & 15; return 8 * (i >> 2) + 4 * n + (i & 3); }

__host__ __device__ __forceinline__ size_t tiled_off(int row, int col, int K) { return ((size_t)((row >> 8) * (K >> 6) + (col >> 6)) * 2 + ((row >> 7) & 1)) * 16384 + (size_t)lds_byte(row & 127, col & 63); }
__host__ __device__ __forceinline__ int inv_perm32(int c) { return ((c >> 2) & 1) * 16 + (((c >> 3) << 2) | (c & 3)); }
struct Unit { int pm, pn; };
struct Gemm { const bf16_t* A; const bf16_t* Bt; int M, N, K; int nt, ntm, jt; };

struct StaticOrder {
    int nM, nN, nwg, G, c, wgm;
    __host__ __device__ void init(int M, int N, int G_, int c_, int wgm_ = WGM) { nM = M / BM; nN = N / BM; nwg = nM * nN; G = G_; c = c_; wgm = wgm_; }
    __host__ __device__ bool next(int i, Unit& u) const {
        const long L = (long)i * G + c; if (L >= nwg) return false;
        int wgid = (int)L; { const int q = nwg / NXCD, r = nwg % NXCD, xcd = wgid % NXCD, off = wgid / NXCD; wgid = (xcd < r ? xcd * (q + 1) : r * (q + 1) + (xcd - r) * q) + off; }
        const int nig = wgm * nN, gid = wgid / nig, fm = gid * wgm, gsz = (nM - fm) < wgm ? (nM - fm) : wgm;
        u.pm = fm + ((wgid % nig) % gsz); u.pn = (wgid % nig) / gsz; return true;
    }
    __device__ __forceinline__ void a_ready(const Unit&) const {}
    __device__ __forceinline__ void done(const Unit&) const {}
};

typedef float f32x2_t __attribute__((ext_vector_type(2))); typedef __bf16 bf16x2_t __attribute__((ext_vector_type(2)));
__device__ __forceinline__ unsigned cvt_pk_bf16(float lo, float hi) { f32x2_t v = {lo, hi}; bf16x2_t b = __builtin_convertvector(v, bf16x2_t); return __builtin_bit_cast(unsigned, b); }
__device__ __forceinline__ float fast_sigmoid(float x) { return __builtin_amdgcn_rcpf(1.0f + __builtin_amdgcn_exp2f(-1.4426950408889634f * x)); }
__device__ __forceinline__ float fast_silu(float x) { return x * fast_sigmoid(x); }
__device__ __forceinline__ float bf_lo(unsigned w) { return __builtin_bit_cast(float, w << 16); }
__device__ __forceinline__ float bf_hi(unsigned w) { return __builtin_bit_cast(float, w & 0xffff0000u); }

struct EpiSwiGLU {
    static constexpr bool PERM = true, AFTER_DRAIN = false, RS_LDS = true;
    __device__ __forceinline__ void prefetch(const Unit&, int, int, int, int, PG8_LAS unsigned char*) const {}
    bf16_t* H; int ldh; const float* rs; const PG8_LAS float* rl;
    __device__ __forceinline__ void operator()(const f32x4 (&acc)[2][2][4][2], const Unit& u, int wr, int wc, int fr, int fq) const {
        const int row0 = u.pm * BM + wr * 64 + fr, col0 = u.pn * HALF + wc * 32 + 8 * fq;
        float rr[2][4];
#pragma unroll
        for (int ai = 0; ai < 2; ++ai)
#pragma unroll
            for (int m = 0; m < 4; ++m) rr[ai][m] = rl[wr * 64 + fr + ai * HALF + m * 16];
#pragma unroll
        for (int ai = 0; ai < 2; ++ai)
#pragma unroll
            for (int m = 0; m < 4; ++m) { bf16_t* rowp = (bf16_t*)((unsigned char*)H + tiled_off(row0 + ai * HALF + m * 16, col0, ldh));
                const float r_ = rr[ai][m];
                const f32x4 g0 = acc[ai][0][m][0] * r_, g1 = acc[ai][0][m][1] * r_, u0 = acc[ai][1][m][0] * r_, u1 = acc[ai][1][m][1] * r_;
                u32x4 w; w.x = cvt_pk_bf16(fast_silu(g0[0]) * u0[0], fast_silu(g0[1]) * u0[1]); w.y = cvt_pk_bf16(fast_silu(g0[2]) * u0[2], fast_silu(g0[3]) * u0[3]);
                w.z = cvt_pk_bf16(fast_silu(g1[0]) * u1[0], fast_silu(g1[1]) * u1[1]); w.w = cvt_pk_bf16(fast_silu(g1[2]) * u1[2], fast_silu(g1[3]) * u1[3]);
                __builtin_nontemporal_store(w, (u32x4*)rowp); }
    }
};
struct EpiResid {
    static constexpr bool PERM = false, AFTER_DRAIN = false;
    __device__ __forceinline__ void prefetch(const Unit&, int, int, int, int, PG8_LAS unsigned char*) const {}
    const float* R; float* O; int ld; float alpha;
    __device__ __forceinline__ void operator()(const f32x4 (&acc)[2][2][4][2], const Unit& u, int wr, int wc, int fr, int fq) const {
        const int row0 = u.pm * BM + wr * 64 + fr, col0 = u.pn * BM + wc * 32 + 4 * fq;
#pragma unroll
        for (int ai = 0; ai < 2; ++ai)
#pragma unroll
            for (int m = 0; m < 4; ++m) { const size_t off = (size_t)(row0 + ai * HALF + m * 16) * ld + col0;
#pragma unroll
                for (int bj = 0; bj < 2; ++bj)
#pragma unroll
                    for (int n = 0; n < 2; ++n) { const f32x4 r = *(const f32x4*)(R + off + bj * HALF + n * 16); *(f32x4*)(O + off + bj * HALF + n * 16) = r + acc[ai][bj][m][n] * alpha; } }
    }
};
template <bool RF32> struct EpiResidBf {
    static constexpr bool PERM = true, AFTER_DRAIN = false, RS_LDS = false;
    const void* R; bf16_t* O; int ld; float alpha; float* part;
    __device__ __forceinline__ void prefetch(const Unit& u, int wr, int wc, int fr, int fq, PG8_LAS unsigned char* scratch) const {
        const char* p = (const char*)R + ((size_t)(u.pm * BM + wr * 64 + fr) * ld + u.pn * BM + wc * 32 + 8 * fq) * (RF32 ? 4 : 2);
        const size_t rstep = (size_t)16 * ld * (RF32 ? 4 : 2);
#pragma unroll
        for (int i = 0; i < 8; ++i) {
#pragma unroll
            for (int bj = 0; bj < 2; ++bj) {
                __builtin_amdgcn_global_load_lds((const unsigned*)(p + bj * HALF * (RF32 ? 4 : 2)), (PG8_LAS unsigned*)scratch, 16, 0, 0);
                if (RF32) __builtin_amdgcn_global_load_lds((const unsigned*)(p + bj * HALF * 4 + 16), (PG8_LAS unsigned*)scratch, 16, 0, 0); }
            p += (i == 3) ? 5 * rstep : rstep; asm volatile("" : "+v"(p)); }
    }
    __device__ __forceinline__ void operator()(const f32x4 (&acc)[2][2][4][2], const Unit& u, int wr, int wc, int fr, int fq) const {
        const int row0 = u.pm * BM + wr * 64 + fr, col0 = u.pn * BM + wc * 32 + 8 * fq;
        float sq[2][4] = {{0.f, 0.f, 0.f, 0.f}, {0.f, 0.f, 0.f, 0.f}};
        if constexpr (!RF32) {
            u32x4 rw[2][4][2];
#pragma unroll
            for (int ai = 0; ai < 2; ++ai)
#pragma unroll
                for (int m = 0; m < 4; ++m)
#pragma unroll
                    for (int bj = 0; bj < 2; ++bj) rw[ai][m][bj] = *(const u32x4*)((const unsigned char*)R + tiled_off(row0 + ai * HALF + m * 16, col0 + bj * HALF, ld));
#pragma unroll
            for (int ai = 0; ai < 2; ++ai)
#pragma unroll
                for (int m = 0; m < 4; ++m)
#pragma unroll
                    for (int bj = 0; bj < 2; ++bj) { const u32x4 w_ = rw[ai][m][bj];
                        const f32x4 r0 = (f32x4){bf_lo(w_.x), bf_hi(w_.x), bf_lo(w_.y), bf_hi(w_.y)}, r1 = (f32x4){bf_lo(w_.z), bf_hi(w_.z), bf_lo(w_.w), bf_hi(w_.w)};
                        const f32x4 o0 = r0 + acc[ai][bj][m][0] * alpha, o1 = r1 + acc[ai][bj][m][1] * alpha;
                        sq[ai][m] += (o0[0] * o0[0] + o0[1] * o0[1]) + (o0[2] * o0[2] + o0[3] * o0[3]) + (o1[0] * o1[0] + o1[1] * o1[1]) + (o1[2] * o1[2] + o1[3] * o1[3]);
                        u32x4 w; w.x = cvt_pk_bf16(o0[0], o0[1]); w.y = cvt_pk_bf16(o0[2], o0[3]); w.z = cvt_pk_bf16(o1[0], o1[1]); w.w = cvt_pk_bf16(o1[2], o1[3]);
                        *(u32x4*)((unsigned char*)O + tiled_off(row0 + ai * HALF + m * 16, col0 + bj * HALF, ld)) = w; }
        } else {
#pragma unroll
        for (int ai = 0; ai < 2; ++ai) {
            f32x4 r0[4][2], r1[4][2];
#pragma unroll
            for (int m = 0; m < 4; ++m)
#pragma unroll
                for (int bj = 0; bj < 2; ++bj) { const size_t off = (size_t)(row0 + ai * HALF + m * 16) * ld + col0 + bj * HALF;
                    r0[m][bj] = *(const f32x4*)((const float*)R + off); r1[m][bj] = *(const f32x4*)((const float*)R + off + 4); }
#pragma unroll
            for (int m = 0; m < 4; ++m)
#pragma unroll
                for (int bj = 0; bj < 2; ++bj) {
                    const f32x4 o0 = r0[m][bj] + acc[ai][bj][m][0] * alpha, o1 = r1[m][bj] + acc[ai][bj][m][1] * alpha;
                    sq[ai][m] += (o0[0] * o0[0] + o0[1] * o0[1]) + (o0[2] * o0[2] + o0[3] * o0[3]) + (o1[0] * o1[0] + o1[1] * o1[1]) + (o1[2] * o1[2] + o1[3] * o1[3]);
                    u32x4 w; w.x = cvt_pk_bf16(o0[0], o0[1]); w.y = cvt_pk_bf16(o0[2], o0[3]); w.z = cvt_pk_bf16(o1[0], o1[1]); w.w = cvt_pk_bf16(o1[2], o1[3]);
                    *(u32x4*)((unsigned char*)O + tiled_off(row0 + ai * HALF + m * 16, col0 + bj * HALF, ld)) = w; }
        }
        }
#pragma unroll
        for (int ai = 0; ai < 2; ++ai)
#pragma unroll
            for (int m = 0; m < 4; ++m) { float s_ = sq[ai][m]; s_ += __shfl_xor(s_, 16); s_ += __shfl_xor(s_, 32);
                if (fq == 0) part[(size_t)(u.pn * 4 + wc) * (size_t)32768 + row0 + ai * HALF + m * 16] = s_; }
    }
};
struct EpiStoreBf {
    static constexpr bool PERM = true, AFTER_DRAIN = false, RS_LDS = false;
    __device__ __forceinline__ void prefetch(const Unit&, int, int, int, int, PG8_LAS unsigned char*) const {}
    bf16_t* O; int ld; float alpha;
    __device__ __forceinline__ void operator()(const f32x4 (&acc)[2][2][4][2], const Unit& u, int wr, int wc, int fr, int fq) const {
        const int row0 = u.pm * BM + wr * 64 + fr, col0 = u.pn * BM + wc * 32 + 8 * fq;
#pragma unroll
        for (int ai = 0; ai < 2; ++ai)
#pragma unroll
            for (int m = 0; m < 4; ++m)
#pragma unroll
                for (int bj = 0; bj < 2; ++bj) { const size_t off = (size_t)(row0 + ai * HALF + m * 16) * ld + col0 + bj * HALF; const f32x4 o0 = acc[ai][bj][m][0] * alpha, o1 = acc[ai][bj][m][1] * alpha;
                    u32x4 w; w.x = cvt_pk_bf16(o0[0], o0[1]); w.y = cvt_pk_bf16(o0[2], o0[3]); w.z = cvt_pk_bf16(o1[0], o1[1]); w.w = cvt_pk_bf16(o1[2], o1[3]);
                    *(u32x4*)(O + off) = w; }
    }
};
struct EpiProj {
    static constexpr bool PERM = true, AFTER_DRAIN = false, RS_LDS = true;
    __device__ __forceinline__ void prefetch(const Unit&, int, int, int, int, PG8_LAS unsigned char*) const {}
    unsigned char* base;
    const float* rs;
    const PG8_LAS float* rl;
    float* kmean;
    __device__ __forceinline__ void operator()(const f32x4 (&acc)[2][2][4][2], const Unit& u, int wr, int wc, int fr, int fq) const {
        const int pn = u.pn; const int row0 = u.pm * BM + wr * 64 + fr;
        float rr[2][4];
#pragma unroll
        for (int ai = 0; ai < 2; ++ai)
#pragma unroll
            for (int m = 0; m < 4; ++m) rr[ai][m] = rl[wr * 64 + fr + ai * HALF + m * 16];
        if (pn == 40) {
            if (wc == 0 && fq < 2) { float* G = (float*)(base + (size_t)640 * 1048576);
#pragma unroll
                for (int ai = 0; ai < 2; ++ai)
#pragma unroll
                    for (int m = 0; m < 4; ++m) { float* rowp = G + (size_t)(row0 + ai * HALF + m * 16) * 16 + 8 * fq; *(f32x4*)rowp = acc[ai][0][m][0] * rr[ai][m]; *(f32x4*)(rowp + 4) = acc[ai][0][m][1] * rr[ai][m]; } }
            return;
        }
        size_t boff; int ld, t0, act = 0; bool gran = false;
        if (pn < 2) { boff = 0; ld = 512; t0 = 0; gran = true; } else if (pn < 4) { boff = 32; ld = 512; t0 = 2; gran = true; } else if (pn < 8) { boff = 64; ld = 1024; t0 = 4; }
        else if (pn < 12) { boff = 128; ld = 1024; t0 = 8; act = 1; gran = true; } else if (pn < 16) { boff = 192; ld = 1024; t0 = 12; } else if (pn < 20) { boff = 256; ld = 1024; t0 = 16; }
        else if (pn < 24) { boff = 320; ld = 1024; t0 = 20; } else if (pn < 32) { boff = 384; ld = 2048; t0 = 24; act = 2; } else { boff = 512; ld = 2048; t0 = 32; act = 2; }
        bf16_t* O = (bf16_t*)(base + boff * 1048576); const int col0 = (pn - t0) * BM + wc * 32 + 8 * fq;
        if (pn >= 16 && pn < 20) {
#pragma unroll
            for (int bj = 0; bj < 2; ++bj) { f32x4 s0 = {0.f, 0.f, 0.f, 0.f}, s1 = {0.f, 0.f, 0.f, 0.f};
#pragma unroll
                for (int ai = 0; ai < 2; ++ai)
#pragma unroll
                    for (int m = 0; m < 4; ++m) { s0 = s0 + acc[ai][bj][m][0] * rr[ai][m]; s1 = s1 + acc[ai][bj][m][1] * rr[ai][m]; }
#pragma unroll
                for (int j = 0; j < 4; ++j) {
#pragma unroll
                    for (int o = 1; o < 16; o <<= 1) { s0[j] += __shfl_xor(s0[j], o); s1[j] += __shfl_xor(s1[j], o); } }
                if (fr == 0) { float* kp = kmean + (size_t)u.pm * 1024 + col0 + bj * HALF;
#pragma unroll
                    for (int j = 0; j < 4; ++j) { atomicAdd(kp + j, s0[j] * (1.0f / 256.0f)); atomicAdd(kp + 4 + j, s1[j] * (1.0f / 256.0f)); } } }
        }
#pragma unroll
        for (int ai = 0; ai < 2; ++ai)
#pragma unroll
            for (int m = 0; m < 4; ++m) { bf16_t* rowp = O + (size_t)(row0 + ai * HALF + m * 16) * ld + col0;
#pragma unroll
                for (int bj = 0; bj < 2; ++bj) { f32x4 v0 = acc[ai][bj][m][0] * rr[ai][m], v1 = acc[ai][bj][m][1] * rr[ai][m];
                    if (act == 1) {
#pragma unroll
                        for (int j = 0; j < 4; ++j) { v0[j] = fast_silu(v0[j]); v1[j] = fast_silu(v1[j]); } }
                    else if (act == 2) {
#pragma unroll
                        for (int j = 0; j < 4; ++j) { v0[j] = fast_sigmoid(v0[j]); v1[j] = fast_sigmoid(v1[j]); } }
                    u32x4 w; w.x = cvt_pk_bf16(v0[0], v0[1]); w.y = cvt_pk_bf16(v0[2], v0[3]); w.z = cvt_pk_bf16(v1[0], v1[1]); w.w = cvt_pk_bf16(v1[2], v1[3]);
                    if (act == 2) {
                        const int lane_ = fq * 16 + fr, wv = wr * 4 + wc, grp = (ai * 4 + m) * 2 + bj;
                        *(u32x4*)(O + ((((size_t)(u.pm * 8 + (pn - t0)) * 8 + wv) * 16 + grp) * 64 + lane_) * 8) = w; }
                    else if (gran) { const int row = row0 + ai * HALF + m * 16, c = col0 + bj * HALF; typedef unsigned u32x2_t __attribute__((ext_vector_type(2)));
                        bf16_t* gp = O + ((size_t)((row >> 5) * (ld >> 2) + (c >> 2)) * 32 + (row & 31)) * 4;
                        *(u32x2_t*)gp = (u32x2_t){w.x, w.y}; *(u32x2_t*)(gp + 128) = (u32x2_t){w.z, w.w}; }
                    else __builtin_nontemporal_store(w, (u32x4*)(rowp + bj * HALF)); } }
    }
};
template <bool ACCUM> struct EpiGateMul {
    static constexpr bool PERM = true, AFTER_DRAIN = false, RS_LDS = false;
    __device__ __forceinline__ void prefetch(const Unit&, int, int, int, int, PG8_LAS unsigned char*) const {}
    bf16_t* G; bf16_t* T; bf16_t* Y; int ld;
    __device__ __forceinline__ void operator()(const f32x4 (&acc)[2][2][4][2], const Unit& u, int wr, int wc, int fr, int fq) const {
        const int row0 = u.pm * BM + wr * 64 + fr, col0 = u.pn * BM + wc * 32 + 8 * fq;
        const size_t lp0 = (((size_t)(u.pm * 8 + u.pn) * 8 + (wr * 4 + wc)) * 16) * 64 + (fq * 16 + fr);
#pragma unroll
        for (int ai = 0; ai < 2; ++ai) {
            u32x4 gw[4][2], tw[4][2];
#pragma unroll
            for (int m = 0; m < 4; ++m)
#pragma unroll
                for (int bj = 0; bj < 2; ++bj) { const size_t lp = (lp0 + (size_t)((ai * 4 + m) * 2 + bj) * 64) * 8;
                    gw[m][bj] = *(const u32x4*)(G + lp); if (ACCUM) tw[m][bj] = *(const u32x4*)(T + lp); }
#pragma unroll
            for (int m = 0; m < 4; ++m)
#pragma unroll
                for (int bj = 0; bj < 2; ++bj) { const size_t lp = (lp0 + (size_t)((ai * 4 + m) * 2 + bj) * 64) * 8;
                    const f32x4 a0 = acc[ai][bj][m][0], a1 = acc[ai][bj][m][1]; const u32x4 g = gw[m][bj];
                    float v[8] = {bf_lo(g.x) * a0[0], bf_hi(g.x) * a0[1], bf_lo(g.y) * a0[2], bf_hi(g.y) * a0[3], bf_lo(g.z) * a1[0], bf_hi(g.z) * a1[1], bf_lo(g.w) * a1[2], bf_hi(g.w) * a1[3]};
                    if (ACCUM) { const u32x4 y = tw[m][bj];
                        v[0] += bf_lo(y.x); v[1] += bf_hi(y.x); v[2] += bf_lo(y.y); v[3] += bf_hi(y.y); v[4] += bf_lo(y.z); v[5] += bf_hi(y.z); v[6] += bf_lo(y.w); v[7] += bf_hi(y.w); }
                    u32x4 w; w.x = cvt_pk_bf16(v[0], v[1]); w.y = cvt_pk_bf16(v[2], v[3]); w.z = cvt_pk_bf16(v[4], v[5]); w.w = cvt_pk_bf16(v[6], v[7]);
                    if (ACCUM) *(u32x4*)((unsigned char*)Y + tiled_off(row0 + ai * HALF + m * 16, col0 + bj * HALF, ld)) = w; else *(u32x4*)(G + lp) = w; }
        }
    }
};

template <class Epi, class Sched, bool ALIGN_EPI = false, bool SP2 = false>
__device__ __forceinline__ void gemm_phase(PG8_LAS unsigned char* lds, const Gemm g, const Sched& S, const Epi& E) {
    int tid_ = threadIdx.x; asm volatile("" : "+v"(tid_));
    const int tid = tid_, wid = __builtin_amdgcn_readfirstlane(tid >> 6), lane = tid & 63, wr = wid >> 2, wc = wid & 3, fr = lane & 15, fq = lane >> 4;
    const int K = g.K, nt = g.nt ? g.nt : K / BK, ntm = g.nt ? g.ntm : nt, jt = g.nt ? g.jt : 0;
    unsigned voffA[2], voffB[2];
#pragma unroll
    for (int i = 0; i < 2; ++i) { voffA[i] = (unsigned)(tid * 16 + i * 8192); voffB[i] = voffA[i]; }
    const size_t kstep = 32768;
    const size_t hstep = 16384;
    const size_t tstep = (size_t)(K / BK) * kstep;
    const unsigned ldsw = (unsigned)wid * 1024u;
    const int aoff = lds_byte(wr * 64 + fr, fq * 8), boff = lds_byte(wc * 32 + fr, fq * 8);
#define PG8_SA(b, h) (((b) * 2 + (h)) * HTB)
#define PG8_SB(b, h) ((4 + (b) * 2 + (h)) * HTB)
#define PG8_STAGE(bufoff, gbase, voff) do { _Pragma("unroll") for (int _i = 0; _i < 2; ++_i) \
        __builtin_amdgcn_global_load_lds((const unsigned*)((const char*)(gbase) + (voff)[_i]), (PG8_LAS unsigned*)(lds + (bufoff) + ldsw + _i * 8192), 16, 0, 0); } while (0)
#define PG8_LDA(dst, b, h) do { _Pragma("unroll") for (int m = 0; m < 4; ++m) _Pragma("unroll") for (int k = 0; k < 2; ++k) dst[m][k] = *(const PG8_LAS bf16x8*)(lds + PG8_SA(b, h) + aoff + m * 2048 + k * 1024); } while (0)
#define PG8_LDB(dst, b, h) do { _Pragma("unroll") for (int n = 0; n < 2; ++n) _Pragma("unroll") for (int k = 0; k < 2; ++k) dst[n][k] = *(const PG8_LAS bf16x8*)(lds + PG8_SB(b, h) + boff + n * 2048 + k * 1024); } while (0)
#define PG8_MMA(ai, bj, At, Bt) do { __builtin_amdgcn_s_setprio(1); _Pragma("unroll") for (int m = 0; m < 4; ++m) _Pragma("unroll") for (int n = 0; n < 2; ++n) _Pragma("unroll") for (int k = 0; k < 2; ++k) \
        acc[ai][bj][m][n] = __builtin_amdgcn_mfma_f32_16x16x32_bf16(Bt[n][k], At[m][k], acc[ai][bj][m][n], 0, 0, 0); __builtin_amdgcn_s_setprio(0); } while (0)
#define PG8_WAIT_V(n) asm volatile("s_waitcnt vmcnt(" #n ")" ::: "memory")
#define PG8_WAIT_L(n) asm volatile("s_waitcnt lgkmcnt(" #n ")" ::: "memory")
#define PG8_BAR __builtin_amdgcn_s_barrier()
#define PG8_SCHED __builtin_amdgcn_sched_barrier(0)
    Unit cur, nxt; int ui = 0;
    if (!S.next(0, cur)) return;
    f32x4 acc[2][2][4][2];
#pragma unroll
    for (int a = 0; a < 2; ++a)
#pragma unroll
        for (int b = 0; b < 2; ++b)
#pragma unroll
            for (int m = 0; m < 4; ++m)
#pragma unroll
                for (int n = 0; n < 2; ++n) acc[a][b][m][n] = (f32x4){0.f, 0.f, 0.f, 0.f};
    bf16x8 At[4][2], B0[2][2], B1[2][2];
    const char* cA = (const char*)g.A + (size_t)cur.pm * tstep; const char* cB = (const char*)g.Bt + (size_t)cur.pn * tstep;
    S.a_ready(cur);
    Epi El = E;
#define PG8_RS_PREFETCH(u_, ui_) do { if constexpr (Epi::RS_LDS) { if (wid < 4) __builtin_amdgcn_global_load_lds((const unsigned*)(E.rs + (u_).pm * BM + wid * 64 + lane), \
        (PG8_LAS unsigned*)(lds + STAGE_BYTES + ((ui_) & 1) * 1024 + wid * 256), 4, 0, 0); } } while (0)
    PG8_RS_PREFETCH(cur, 0);
    if constexpr (SP2) {
        PG8_STAGE(PG8_SB(0, 0), cB, voffB); PG8_STAGE(PG8_SB(0, 1), cB + hstep, voffB); PG8_STAGE(PG8_SA(0, 0), cA, voffA); PG8_STAGE(PG8_SA(0, 1), cA + hstep, voffA);
        if (wr == 1) PG8_BAR;
        PG8_WAIT_V(2); PG8_BAR;
        PG8_STAGE(PG8_SB(1, 0), cB + kstep, voffB); PG8_STAGE(PG8_SA(1, 0), cA + kstep, voffA); PG8_STAGE(PG8_SB(1, 1), cB + hstep + kstep, voffB);
        PG8_WAIT_V(6); PG8_BAR;
    } else {
        PG8_STAGE(PG8_SB(0, 0), cB, voffB); PG8_STAGE(PG8_SA(0, 0), cA, voffA); PG8_STAGE(PG8_SB(0, 1), cB + hstep, voffB); PG8_STAGE(PG8_SA(0, 1), cA + hstep, voffA);
        if (wr == 1) PG8_BAR;
        PG8_WAIT_V(4); PG8_BAR;
        PG8_STAGE(PG8_SB(1, 0), cB + kstep, voffB); PG8_STAGE(PG8_SA(1, 0), cA + kstep, voffA); PG8_STAGE(PG8_SB(1, 1), cB + hstep + kstep, voffB);
        PG8_WAIT_V(6); PG8_BAR;
    }
    for (;;) {
        const bool has_next = S.next(ui + 1, nxt);
        const char* nA = has_next ? (const char*)g.A + (size_t)nxt.pm * tstep : cA; const char* nB = has_next ? (const char*)g.Bt + (size_t)nxt.pn * tstep : cB;
        for (int t = 0; t < nt; t += 2) {
            const bool last = (t == nt - 2);
#define PG8_KO(tt) ((size_t)(tt) * kstep + ((tt) >= ntm ? jmp : (size_t)0))
            const size_t jmp = (size_t)(cur.pn * jt) * kstep;
            const char* a1 = cA + PG8_KO(t + 1);
            const char* a2 = last ? nA : cA + PG8_KO(t + 2); const char* b2 = last ? nB : cB + PG8_KO(t + 2);
            const char* a3 = last ? nA + kstep : cA + PG8_KO(t + 3); const char* b3 = last ? nB + kstep : cB + PG8_KO(t + 3);
#undef PG8_KO
            if (last && has_next) S.a_ready(nxt);
            if constexpr (SP2) {
            PG8_LDB(B0, 0, 0); PG8_LDB(B1, 0, 1); PG8_SCHED; PG8_LDA(At, 0, 0); PG8_STAGE(PG8_SA(1, 1), a1 + hstep, voffA);
            PG8_WAIT_V(8); PG8_WAIT_L(0); PG8_BAR; PG8_MMA(0, 0, At, B0); PG8_MMA(0, 1, At, B1); PG8_BAR; PG8_SCHED;
            PG8_LDA(At, 0, 1); PG8_STAGE(PG8_SB(0, 0), b2, voffB); PG8_STAGE(PG8_SB(0, 1), b2 + hstep, voffB); PG8_STAGE(PG8_SA(0, 0), a2, voffA);
            PG8_WAIT_V(8); PG8_WAIT_L(0); PG8_BAR; PG8_MMA(1, 0, At, B0); PG8_MMA(1, 1, At, B1); PG8_BAR; PG8_SCHED;
            PG8_LDB(B0, 1, 0); PG8_LDB(B1, 1, 1); PG8_SCHED; PG8_LDA(At, 1, 0); PG8_STAGE(PG8_SA(0, 1), a2 + hstep, voffA);
            PG8_WAIT_V(8); PG8_WAIT_L(0); PG8_BAR; PG8_MMA(0, 0, At, B0); PG8_MMA(0, 1, At, B1); PG8_BAR; PG8_SCHED;
            PG8_LDA(At, 1, 1); PG8_STAGE(PG8_SB(1, 0), b3, voffB); PG8_STAGE(PG8_SB(1, 1), b3 + hstep, voffB); PG8_STAGE(PG8_SA(1, 0), a3, voffA);
            PG8_WAIT_V(8); PG8_WAIT_L(0); PG8_BAR; PG8_MMA(1, 0, At, B0); PG8_MMA(1, 1, At, B1); PG8_BAR; PG8_SCHED;
            } else {
            PG8_LDB(B0, 0, 0); PG8_SCHED; PG8_LDA(At, 0, 0); PG8_STAGE(PG8_SA(1, 1), a1 + hstep, voffA);
            PG8_WAIT_L(8); PG8_BAR; PG8_WAIT_L(0); PG8_MMA(0, 0, At, B0); PG8_BAR; PG8_SCHED;
            PG8_LDB(B1, 0, 1); PG8_STAGE(PG8_SB(0, 0), b2, voffB);
            PG8_BAR; PG8_WAIT_L(0); PG8_MMA(0, 1, At, B1); PG8_BAR;
            PG8_LDA(At, 0, 1); PG8_STAGE(PG8_SA(0, 0), a2, voffA);
            PG8_BAR; PG8_WAIT_L(0); PG8_MMA(1, 0, At, B0); PG8_BAR; PG8_SCHED;
            PG8_STAGE(PG8_SB(0, 1), b2 + hstep, voffB);
            PG8_WAIT_V(6); PG8_BAR; PG8_MMA(1, 1, At, B1); PG8_BAR;
            PG8_LDB(B0, 1, 0); PG8_SCHED; PG8_LDA(At, 1, 0); PG8_STAGE(PG8_SA(0, 1), a2 + hstep, voffA);
            PG8_WAIT_L(8); PG8_BAR; PG8_WAIT_L(0); PG8_MMA(0, 0, At, B0); PG8_BAR; PG8_SCHED;
            PG8_LDB(B1, 1, 1); PG8_STAGE(PG8_SB(1, 0), b3, voffB);
            PG8_BAR; PG8_WAIT_L(0); PG8_MMA(0, 1, At, B1); PG8_BAR;
            PG8_LDA(At, 1, 1); PG8_STAGE(PG8_SA(1, 0), a3, voffA);
            PG8_BAR; PG8_WAIT_L(0); PG8_MMA(1, 0, At, B0); PG8_BAR; PG8_SCHED;
            PG8_STAGE(PG8_SB(1, 1), b3 + hstep, voffB);
            PG8_WAIT_V(6); PG8_BAR; PG8_MMA(1, 1, At, B1); PG8_BAR;
            }
        }
        if constexpr (ALIGN_EPI) { if (wr == 0) PG8_BAR; }
        if constexpr (Epi::RS_LDS) El.rl = (const PG8_LAS float*)(lds + STAGE_BYTES + (ui & 1) * 1024);
        if constexpr (!Epi::AFTER_DRAIN) { El(acc, cur, wr, wc, fr, fq); S.done(cur); }
        if (!has_next) break;
#pragma unroll
        for (int a = 0; a < 2; ++a)
#pragma unroll
            for (int b = 0; b < 2; ++b)
#pragma unroll
                for (int m = 0; m < 4; ++m)
#pragma unroll
                    for (int n = 0; n < 2; ++n) acc[a][b][m][n] = (f32x4){0.f, 0.f, 0.f, 0.f};
        cur = nxt; cA = nA; cB = nB; ++ui;
        PG8_RS_PREFETCH(cur, ui);
        if constexpr (ALIGN_EPI) { if (wr == 1) PG8_BAR; }
    }
    PG8_WAIT_V(0);
    if constexpr (!ALIGN_EPI) { if (wr == 0) PG8_BAR; }
    PG8_BAR;
    if constexpr (Epi::AFTER_DRAIN) { El.fused(acc, cur, wr, wc, fr, fq, lds, wid, lane); S.done(cur); }
#undef PG8_SA
#undef PG8_SB
#undef PG8_STAGE
#undef PG8_LDA
#undef PG8_LDB
#undef PG8_MMA
#undef PG8_RS_PREFETCH
#undef PG8_WAIT_V
#undef PG8_WAIT_L
#undef PG8_BAR
#undef PG8_SCHED
}
}

#define GAS __attribute__((address_space(1)))
#define LAS __attribute__((address_space(3)))
typedef unsigned short bf16;
typedef unsigned v4u __attribute__((ext_vector_type(4)));
typedef float f32x4 __attribute__((ext_vector_type(4)));
typedef short bf16x8 __attribute__((ext_vector_type(8)));
typedef GAS unsigned gu32;
typedef GAS unsigned long long gu64;
#define RLX_AGENT __ATOMIC_RELAXED, __HIP_MEMORY_SCOPE_AGENT
#define LDS_WAIT() asm volatile("s_waitcnt lgkmcnt(0)" ::: "memory")
#define VM_WAIT() asm volatile("s_waitcnt vmcnt(0)" ::: "memory")
__device__ __forceinline__ unsigned long long rt() { return __builtin_amdgcn_s_memrealtime(); }
__device__ __forceinline__ unsigned f2bf(float f) { unsigned u = __builtin_bit_cast(unsigned, f); return (u + 0x7fffu + ((u >> 16) & 1u)) >> 16; }
__device__ __forceinline__ unsigned pk2(float lo, float hi) { return f2bf(lo) | (f2bf(hi) << 16); }

#define XB_TMO      128
#define XB_XCNT(j)  (256  + 64 * (j))
#define XB_XSUB(j)  (1280 + 64 * (j))
#define XB_XGEN(j)  (2304 + 64 * (j))
#define XB_TOP      3328
#define XB_TOPGEN   3392
#define XCD_BAR_WORDS 3456
#define XB_SPIN_CAP (1u << 18)

__device__ __forceinline__ unsigned xb_ld(unsigned* p)              { return __hip_atomic_load(p, __ATOMIC_RELAXED, __HIP_MEMORY_SCOPE_AGENT); }
__device__ __forceinline__ unsigned xb_add(unsigned* p, unsigned v) { return __hip_atomic_fetch_add(p, v, __ATOMIC_RELAXED, __HIP_MEMORY_SCOPE_AGENT); }
__device__ __forceinline__ unsigned xb_xcc_id() { return (unsigned)__builtin_amdgcn_s_getreg((3 << 11) | 20) & 0xFu; }
#define XB_SPIN(cond, bar) do { unsigned _sp = 0; while (cond) { __builtin_amdgcn_s_sleep(1); \
    if ((++_sp & 255u) == 0u) { if (xb_ld(&(bar)[XB_TMO])) break; if (_sp > XB_SPIN_CAP) { atomicAdd(&(bar)[XB_TMO], 1u); break; } } } } while (0)

struct XcdBarrier {
    unsigned* bar; unsigned x;
    volatile LAS unsigned* st;
};

__device__ __forceinline__ XcdBarrier xcd_barrier_post(unsigned* bar, volatile LAS unsigned* st) {
    XcdBarrier b; b.bar = bar; b.x = xb_xcc_id(); b.st = st;
    if (threadIdx.x == 0) (void)xb_add(&bar[XB_XCNT(b.x)], 1u);
    return b;
}
__device__ __forceinline__ void xcd_barrier_complete(unsigned* bar, unsigned x, unsigned& nloc, unsigned& nx) {
    const unsigned G = gridDim.x * gridDim.y * gridDim.z;
    unsigned sum, cnt, mine, sp = 0u;
    for (;;) {
        sum = 0u; cnt = 0u; mine = 0u;
#pragma unroll
        for (unsigned j = 0; j < 16; ++j) { const unsigned c = xb_ld(&bar[XB_XCNT(j)]); sum += c; cnt += (c > 0u) ? 1u : 0u; mine = (j == x) ? c : mine; }
        if (sum == G) break;
        __builtin_amdgcn_s_sleep(1);
        if ((++sp & 255u) == 0u) { if (xb_ld(&bar[XB_TMO])) break; if (sp > XB_SPIN_CAP) { atomicAdd(&bar[XB_TMO], 1u); break; } }
    }
    nloc = mine > 0u ? mine : 1u; nx = cnt > 0u ? cnt : 1u;
}

__device__ __forceinline__ void xcd_barrier(const XcdBarrier& b) {
    asm volatile("s_waitcnt vmcnt(0)" ::: "memory");
    __syncthreads();
    if (threadIdx.x == 0) {
        unsigned* bar = b.bar;
        __builtin_amdgcn_s_waitcnt(0);
        unsigned nloc = b.st[0], nx = b.st[1];
        if (nloc == 0u) { xcd_barrier_complete(bar, b.x, nloc, nx); b.st[0] = nloc; b.st[1] = nx; }
        const unsigned old = xb_add(&bar[XB_XSUB(b.x)], 1u);
        const unsigned gen = old / nloc;
        if (old + 1u == (gen + 1u) * nloc) {
            __builtin_amdgcn_fence(__ATOMIC_RELEASE, "agent");
            asm volatile("s_waitcnt vmcnt(0)" ::: "memory");
            const unsigned og = xb_add(&bar[XB_TOP], 1u);
            const unsigned tg = og / nx;
            if (og + 1u == (tg + 1u) * nx) xb_add(&bar[XB_TOPGEN], 1u);
            else XB_SPIN(xb_ld(&bar[XB_TOPGEN]) == tg, bar);
            __builtin_amdgcn_fence(__ATOMIC_ACQUIRE, "agent");
            xb_add(&bar[XB_XGEN(b.x)], 1u);
            asm volatile("s_waitcnt vmcnt(0)" ::: "memory");
        } else {
            XB_SPIN(xb_ld(&bar[XB_XGEN(b.x)]) == gen, bar);
            __builtin_amdgcn_fence(__ATOMIC_ACQUIRE, "agent");
            asm volatile("s_waitcnt vmcnt(0)" ::: "memory");
        }
    }
    __syncthreads();
}
constexpr int NWAVES = 8;
constexpr int BATCH = 4, SEQ = 8192, DM = 2048, DFF = 5632, M = BATCH * SEQ;
constexpr int GLA_H = 4, GLA_DK = 128, GLA_DV = 256, GLA_RANK = 16;
constexpr int MOBA_H = 8, MOBA_HD = 128, MOBA_BLK = 256, MOBA_NB = SEQ / MOBA_BLK;
constexpr int LDH1 = DFF + DM;
constexpr int D_IN = 10256, NPROJ = 10496;
constexpr float NORM_EPS = 1e-6f;
#ifndef MK_NO_GLA
#define MK_NO_GLA 0
#endif
#ifndef MK_NO_MOBA
#define MK_NO_MOBA 0
#endif
#ifndef MK_PROBE_ID
#define MK_PROBE_ID 0
#endif
#ifndef MK_PER_PHASE
#define MK_PER_PHASE 0
#endif
constexpr int N_PHASES = 16;

constexpr size_t MiB = 1u << 20;
constexpr size_t WS_CTL = 0, CTL_ZERO_BYTES = 1 * MiB;
constexpr size_t WS_WGU = 1 * MiB;
constexpr size_t WS_WD = 45 * MiB;
constexpr size_t WS_WIN = 67 * MiB;
constexpr size_t WS_WBG = 108 * MiB;
constexpr size_t WS_WBM = 112 * MiB;
constexpr size_t WS_WO = 116 * MiB;
constexpr size_t WS_XN = 124 * MiB;
constexpr size_t WS_R1 = 252 * MiB;
constexpr size_t WS_GLAS = 894 * MiB;
constexpr size_t WS_MISC = 958 * MiB;
constexpr size_t WS_PSTAT = 962 * MiB;
constexpr size_t WS_WD1 = 968 * MiB;
constexpr size_t WS_END = 998 * MiB;
constexpr size_t R1_GQ = 0, R1_GK = 32 * MiB, R1_GV = 64 * MiB, R1_GR = 128 * MiB, R1_MQ = 192 * MiB, R1_MK = 256 * MiB, R1_MV = 320 * MiB, R1_GA = 384 * MiB, R1_GB = 512 * MiB, R1_GLR = 640 * MiB;
constexpr size_t MISC_DEC = 0, MISC_KMEAN = 1 * MiB, MISC_SEL = 2 * MiB;
constexpr int CW_TMO = 0, CW_CODE = 1, CW_QUEUE = 64, CW_BAR = 4096;

constexpr int RING_OFF = 0, RING_BYTES = 131072;
constexpr int LDS_BYTES = 163840;
constexpr int LDSCTL_OFF = LDS_BYTES - 512, MISC_OFF = LDSCTL_OFF + 320;

struct Frame {
    LAS unsigned char* lds;
    volatile LAS unsigned* MISC;
    gu32* ctl;
    int tid, lane, wave, vcu, G;
};
__device__ __forceinline__ float wave_sum(float v) {
#pragma unroll
    for (int o = 1; o < 64; o <<= 1) v += __shfl_xor(v, o);
    return v;
}
template <class MAP>
__device__ __forceinline__ void transpose_item(const float* W, int K, int N, bf16* WT, int ldw, const MAP& map, LAS float* scr, int item, int lane, const float* gk) {
    const int nblk = (N + 31) / 32, kb = item / nblk, nb = item % nblk, k0 = 64 * kb, n0 = 32 * nb;
    const int nl = (lane & 31) < (N - n0) ? (lane & 31) : (N - 1 - n0);
    const float* src = W + (size_t)(k0 + (lane >> 5)) * N + n0 + nl;
    float v[32];
#pragma unroll
    for (int i = 0; i < 32; ++i) v[i] = src[(size_t)(2 * i) * N];
#pragma unroll
    for (int i = 0; i < 32; ++i) scr[(2 * i + (lane >> 5)) * 33 + (lane & 31)] = v[i];
    LDS_WAIT(); asm volatile("" ::: "memory");
    const int c = lane & 7;
    f32x4 ga = {1.f, 1.f, 1.f, 1.f}, gb = ga;
    if (gk) { ga = *(const GAS f32x4*)(gk + k0 + 8 * c); gb = *(const GAS f32x4*)(gk + k0 + 8 * c + 4); }
#pragma unroll
    for (int j = 0; j < 4; ++j) { const int n = (lane >> 3) + 8 * j; const LAS float* s = scr + (8 * c) * 33 + n;
        v4u o; o.x = pk2(s[0 * 33] * ga.x, s[1 * 33] * ga.y); o.y = pk2(s[2 * 33] * ga.z, s[3 * 33] * ga.w); o.z = pk2(s[4 * 33] * gb.x, s[5 * 33] * gb.y); o.w = pk2(s[6 * 33] * gb.z, s[7 * 33] * gb.w);
        if (n0 + n < N) { const int mr = map(n0 + n), ir = (mr & ~31) + pg8::inv_perm32(mr & 31);
            *(GAS v4u*)((GAS unsigned char*)WT + pg8::tiled_off(ir, k0 + 8 * c, ldw)) = o; } }
    LDS_WAIT(); asm volatile("" ::: "memory");
}
struct MapId { __device__ __forceinline__ int operator()(int n) const { return n; } };
struct MapGU { int up; __device__ __forceinline__ int operator()(int n) const { return 256 * (n >> 7) + 128 * up + (n & 127); } };
struct MapIn { __device__ __forceinline__ int operator()(int n) const { return n < 3072 ? n : (n < 3088 ? 10240 + (n - 3072) : n - 16); } };
template <class MAP>
__device__ __forceinline__ void transpose_weight(Frame& F, const float* W, int K, int N, bf16* WT, const MAP& map, int& cursor, int ldw = 0, const float* gk = nullptr) {
    LAS float* scr = (LAS float*)(F.lds + RING_OFF + F.wave * 16384);
    const int gw = F.vcu * NWAVES + F.wave, NGW = F.G * NWAVES;
    const int nitems = (K / 64) * ((N + 31) / 32);
    int first = (gw - cursor) % NGW; if (first < 0) first += NGW;
    for (int it = first; it < nitems; it += NGW) transpose_item(W, K, N, WT, ldw ? ldw : K, map, scr, it, F.lane, gk);
    cursor = (cursor + nitems) % NGW;
}
struct NoSide { __device__ __forceinline__ void operator()(int, const f32x4 (&)[8]) const {} };
template <int RPW, class LOADROW, class STOREROW, class SIDE = NoSide>
__device__ __forceinline__ void rms_pass(Frame& F, const float* g, const LOADROW& ld, const STOREROW& st, const SIDE& side = SIDE{}) {
    const int gw = F.vcu * NWAVES + F.wave, NGW = F.G * NWAVES;
    f32x4 gv[8];
#pragma unroll
    for (int j = 0; j < 4; ++j) { gv[2 * j] = *(const GAS f32x4*)(g + 512 * j + 8 * F.lane); gv[2 * j + 1] = *(const GAS f32x4*)(g + 512 * j + 8 * F.lane + 4); }
    for (int m0 = gw * RPW; m0 < M; m0 += NGW * RPW) {
        typename LOADROW::Raw raw[RPW];
#pragma unroll
        for (int r = 0; r < RPW; ++r) ld.load(m0 + r, raw[r]);
#pragma unroll
        for (int r = 0; r < RPW; ++r) { f32x4 v[8]; ld.unpack(raw[r], v); side(m0 + r, v); float s = 0.f;
#pragma unroll
            for (int j = 0; j < 8; ++j) s += (v[j].x * v[j].x + v[j].y * v[j].y) + (v[j].z * v[j].z + v[j].w * v[j].w);
            const float rs = 1.0f / sqrtf(wave_sum(s) * (1.0f / DM) + NORM_EPS);
#pragma unroll
            for (int j = 0; j < 8; ++j) v[j] = v[j] * gv[j] * rs;
            st(m0 + r, v); }
    }
}
struct LdRowF32 { struct Raw { f32x4 q[8]; }; const float* X; int lane;
    __device__ __forceinline__ void load(int m, Raw& w) const { const float* xr = X + (size_t)m * DM + 8 * lane;
#pragma unroll
        for (int j = 0; j < 4; ++j) { w.q[2 * j] = *(const GAS f32x4*)(xr + 512 * j); w.q[2 * j + 1] = *(const GAS f32x4*)(xr + 512 * j + 4); } }
    __device__ __forceinline__ void unpack(const Raw& w, f32x4 (&v)[8]) const {
#pragma unroll
        for (int j = 0; j < 8; ++j) v[j] = w.q[j]; } };
struct LdRowBf16 { struct Raw { v4u q[4]; }; const bf16* X; int lane;
    __device__ __forceinline__ void load(int m, Raw& w) const { const bf16* xr = X + (size_t)m * DM + 8 * lane;
#pragma unroll
        for (int j = 0; j < 4; ++j) w.q[j] = *(const GAS v4u*)(xr + 512 * j); }
    __device__ __forceinline__ void unpack(const Raw& w, f32x4 (&v)[8]) const {
#pragma unroll
        for (int j = 0; j < 4; ++j) { const v4u x = w.q[j]; v[2 * j] = (f32x4){pg8::bf_lo(x.x), pg8::bf_hi(x.x), pg8::bf_lo(x.y), pg8::bf_hi(x.y)}; v[2 * j + 1] = (f32x4){pg8::bf_lo(x.z), pg8::bf_hi(x.z), pg8::bf_lo(x.w), pg8::bf_hi(x.w)}; } } };
struct LdRowBf16Sum { struct Raw { v4u q[4], y[4]; }; const bf16* X; const bf16* Y; int lane;
    __device__ __forceinline__ void load(int m, Raw& w) const { const bf16* xr = X + (size_t)m * DM + 8 * lane; const bf16* yr = Y + (size_t)m * DM + 8 * lane;
#pragma unroll
        for (int j = 0; j < 4; ++j) { w.q[j] = *(const GAS v4u*)(xr + 512 * j); w.y[j] = *(const GAS v4u*)(yr + 512 * j); } }
    __device__ __forceinline__ void unpack(const Raw& w, f32x4 (&v)[8]) const {
#pragma unroll
        for (int j = 0; j < 4; ++j) { const v4u x = w.q[j], y = w.y[j];
            v[2 * j] = (f32x4){pg8::bf_lo(x.x) + pg8::bf_lo(y.x), pg8::bf_hi(x.x) + pg8::bf_hi(y.x), pg8::bf_lo(x.y) + pg8::bf_lo(y.y), pg8::bf_hi(x.y) + pg8::bf_hi(y.y)};
            v[2 * j + 1] = (f32x4){pg8::bf_lo(x.z) + pg8::bf_lo(y.z), pg8::bf_hi(x.z) + pg8::bf_hi(y.z), pg8::bf_lo(x.w) + pg8::bf_lo(y.w), pg8::bf_hi(x.w) + pg8::bf_hi(y.w)}; } } };
struct StRowBf16 { bf16* O; int lane; __device__ __forceinline__ void operator()(int m, const f32x4 (&v)[8]) const {
#pragma unroll
    for (int j = 0; j < 4; ++j) { const f32x4 a = v[2 * j], b = v[2 * j + 1]; v4u o; o.x = pk2(a.x, a.y); o.y = pk2(a.z, a.w); o.z = pk2(b.x, b.y); o.w = pk2(b.z, b.w);
        *(GAS v4u*)((GAS unsigned char*)O + pg8::tiled_off(m, 512 * j + 8 * lane, DM)) = o; } } };
struct StRowF32 { float* O; int lane; __device__ __forceinline__ void operator()(int m, const f32x4 (&v)[8]) const { float* orow = O + (size_t)m * DM + 8 * lane;
#pragma unroll
    for (int j = 0; j < 4; ++j) { *(GAS f32x4*)(orow + 512 * j) = v[2 * j]; *(GAS f32x4*)(orow + 512 * j + 4) = v[2 * j + 1]; } } };
struct Side2xBf16 { bf16* O; int ldo; int lane; __device__ __forceinline__ void operator()(int m, const f32x4 (&v)[8]) const { bf16* orow = O + (size_t)m * ldo + 8 * lane;
#pragma unroll
    for (int j = 0; j < 4; ++j) { const f32x4 a = v[2 * j] * 2.0f, b = v[2 * j + 1] * 2.0f; v4u o; o.x = pk2(a.x, a.y); o.y = pk2(a.z, a.w); o.z = pk2(b.x, b.y); o.w = pk2(b.z, b.w); *(GAS v4u*)(orow + 512 * j) = o; } } };
__device__ __forceinline__ void fill_identity(Frame& F, bf16* WT, int n, int ldw, int c0) {
    const size_t nchunks = (size_t)n * (n / 8);
    for (size_t i = (size_t)F.vcu * (NWAVES * 64) + F.tid; i < nchunks; i += (size_t)F.G * NWAVES * 64) { const int row = (int)(i / (n / 8)), c = (int)(i % (n / 8)) * 8;
        v4u o = {0u, 0u, 0u, 0u}; const int d = row - c;
        if (d >= 0 && d < 8) { const unsigned one = (d & 1) ? 0x3F800000u : 0x00003F80u; if ((d >> 1) == 0) o.x = one; else if ((d >> 1) == 1) o.y = one; else if ((d >> 1) == 2) o.z = one; else o.w = one; }
        *(GAS v4u*)(WT + (size_t)row * ldw + c0 + c) = o; }
}
struct LdRowBf16T { struct Raw { v4u q[4]; }; const bf16* X; int lane;
    __device__ __forceinline__ void load(int m, Raw& w) const {
#pragma unroll
        for (int j = 0; j < 4; ++j) w.q[j] = *(const GAS v4u*)((const GAS unsigned char*)X + pg8::tiled_off(m, 512 * j + 8 * lane, DM)); }
    __device__ __forceinline__ void unpack(const Raw& w, f32x4 (&v)[8]) const {
#pragma unroll
        for (int j = 0; j < 4; ++j) { const v4u x = w.q[j]; v[2 * j] = (f32x4){pg8::bf_lo(x.x), pg8::bf_hi(x.x), pg8::bf_lo(x.y), pg8::bf_hi(x.y)}; v[2 * j + 1] = (f32x4){pg8::bf_lo(x.z), pg8::bf_hi(x.z), pg8::bf_lo(x.w), pg8::bf_hi(x.w)}; } } };
struct LdRowBf16SumT { struct Raw { v4u q[4], y[4]; }; const bf16* X; const bf16* Y; int lane;
    __device__ __forceinline__ void load(int m, Raw& w) const { const bf16* yr = Y + (size_t)m * DM + 8 * lane;
#pragma unroll
        for (int j = 0; j < 4; ++j) { w.q[j] = *(const GAS v4u*)((const GAS unsigned char*)X + pg8::tiled_off(m, 512 * j + 8 * lane, DM)); w.y[j] = *(const GAS v4u*)(yr + 512 * j); } }
    __device__ __forceinline__ void unpack(const Raw& w, f32x4 (&v)[8]) const {
#pragma unroll
        for (int j = 0; j < 4; ++j) { const v4u x = w.q[j], y = w.y[j];
            v[2 * j] = (f32x4){pg8::bf_lo(x.x) + pg8::bf_lo(y.x), pg8::bf_hi(x.x) + pg8::bf_hi(y.x), pg8::bf_lo(x.y) + pg8::bf_lo(y.y), pg8::bf_hi(x.y) + pg8::bf_hi(y.y)};
            v[2 * j + 1] = (f32x4){pg8::bf_lo(x.z) + pg8::bf_lo(y.z), pg8::bf_hi(x.z) + pg8::bf_hi(y.z), pg8::bf_lo(x.w) + pg8::bf_lo(y.w), pg8::bf_hi(x.w) + pg8::bf_hi(y.w)}; } } };
struct NoStoreRow { __device__ __forceinline__ void operator()(int, const f32x4 (&)[8]) const {} };
template <int RPW, class LOADROW, class STOREROW>
__device__ __forceinline__ void rs_pass(Frame& F, const LOADROW& ld, const STOREROW& st, float* rs) {
    const int gw = F.vcu * NWAVES + F.wave, NGW = F.G * NWAVES;
    for (int m0 = gw * RPW; m0 < M; m0 += NGW * RPW) {
        typename LOADROW::Raw raw[RPW];
#pragma unroll
        for (int r = 0; r < RPW; ++r) ld.load(m0 + r, raw[r]);
#pragma unroll
        for (int r = 0; r < RPW; ++r) { f32x4 v[8]; ld.unpack(raw[r], v); float s = 0.f;
#pragma unroll
            for (int j = 0; j < 8; ++j) s += (v[j].x * v[j].x + v[j].y * v[j].y) + (v[j].z * v[j].z + v[j].w * v[j].w);
            const float r_ = 1.0f / sqrtf(wave_sum(s) * (1.0f / DM) + NORM_EPS);
            if (F.lane == 0) rs[m0 + r] = r_;
            st(m0 + r, v); }
    }
}
__device__ __forceinline__ void rs_finalize(Frame& F, const float* part, float* rs) {
    for (int row = F.vcu * (NWAVES * 64) + F.tid; row < M; row += F.G * NWAVES * 64) { float s = 0.f;
#pragma unroll
        for (int p_ = 0; p_ < 32; ++p_) s += part[(size_t)p_ * M + row];
        rs[row] = 1.0f / sqrtf(s * (1.0f / DM) + NORM_EPS); }
}
__device__ __forceinline__ void rms_rows_bf16(Frame& F, const float* X, const float* g, bf16* O) { rms_pass<2>(F, g, LdRowF32{X, F.lane}, StRowBf16{O, F.lane}); }
template <bool OUT_F32>
__device__ __forceinline__ void rms_rows_from_bf16(Frame& F, const bf16* X, const float* g, void* Out) {
    if constexpr (OUT_F32) rms_pass<2>(F, g, LdRowBf16{X, F.lane}, StRowF32{(float*)Out, F.lane}); else rms_pass<2>(F, g, LdRowBf16{X, F.lane}, StRowBf16{(bf16*)Out, F.lane});
}
__device__ __forceinline__ void zero_rows_tiled(Frame& F, bf16* WT, int r0, int r1, int K) {
    const size_t nch = (size_t)(r1 - r0) * (K / 8);
    for (size_t i = (size_t)F.vcu * (NWAVES * 64) + F.tid; i < nch; i += (size_t)F.G * NWAVES * 64) { const int r = r0 + (int)(i / (K / 8)), c = (int)(i % (K / 8)) * 8;
        *(GAS v4u*)((GAS unsigned char*)WT + pg8::tiled_off((r & ~31) + pg8::inv_perm32(r & 31), c, K)) = (v4u){0u, 0u, 0u, 0u}; }
}
__device__ __forceinline__ void zero_rows_bf16(Frame& F, bf16* P, size_t nbytes) {
    const size_t n16 = nbytes / 16; GAS v4u* p = (GAS v4u*)P;
    for (size_t i = (size_t)F.vcu * (NWAVES * 64) + F.tid; i < n16; i += (size_t)F.G * NWAVES * 64) p[i] = (v4u){0u, 0u, 0u, 0u};
}

namespace gla {
using bf16x8 = __attribute__((ext_vector_type(8))) short;
using s16x4  = __attribute__((ext_vector_type(4))) short;
using f32x16 = __attribute__((ext_vector_type(16))) float;
using u32x4  = __attribute__((ext_vector_type(4))) unsigned;
using u32x2  = __attribute__((ext_vector_type(2))) unsigned;
constexpr int CH = 128;
constexpr int NCH = SEQ / CH;
constexpr int VSTR = 576, KSTR = 320;
constexpr int L_V = 0, L_K = 73728, L_TOT = 114688, L_PRE = 116736, L_EB = 119296, L_SS = 119808, L_END = 120832;
constexpr float LOG2E = 1.4426950408889634f, LN2 = 0.6931471805599453f, DKS = 0.08838834764831845f;
__device__ __forceinline__ int crow(int r, int hi) { return (r & 3) + 8 * (r >> 2) + 4 * hi; }
typedef float f32x2_t __attribute__((ext_vector_type(2))); typedef __bf16 bf16x2_t __attribute__((ext_vector_type(2)));
__device__ __forceinline__ unsigned cvtpk(float lo, float hi) { f32x2_t v = {lo, hi}; bf16x2_t b = __builtin_convertvector(v, bf16x2_t); return __builtin_bit_cast(unsigned, b); }
__device__ __forceinline__ float bfround(float x) { return __builtin_bit_cast(float, cvtpk(x, 0.f) << 16); }
__device__ __forceinline__ s16x4 tr_read(int addr) { s16x4 r; asm volatile("ds_read_b64_tr_b16 %0, %1" : "=&v"(r) : "v"(addr) : "memory"); return r; }
#define GLA_LWAIT() do { asm volatile("s_waitcnt lgkmcnt(0)" ::: "memory"); __builtin_amdgcn_sched_barrier(0); } while (0)
template <int CTRL, int RMASK, bool BC> __device__ __forceinline__ float dpp_mov(float v) {
    return __builtin_bit_cast(float, __builtin_amdgcn_update_dpp(0, __builtin_bit_cast(int, v), CTRL, RMASK, 0xf, BC)); }
__device__ __forceinline__ float scan32(float v) {
    v += dpp_mov<0x111, 0xf, true>(v); v += dpp_mov<0x112, 0xf, true>(v); v += dpp_mov<0x114, 0xf, true>(v); v += dpp_mov<0x118, 0xf, true>(v);
    v += dpp_mov<0x142, 0xa, false>(v);
    return v;
}
__device__ __forceinline__ bf16x8 pack8(const float* v) { u32x4 w = {cvtpk(v[0], v[1]), cvtpk(v[2], v[3]), cvtpk(v[4], v[5]), cvtpk(v[6], v[7])}; return *reinterpret_cast<bf16x8*>(&w); }
#define GLA_PK(L, H) (bf16x8){L[0], L[1], L[2], L[3], H[0], H[1], H[2], H[3]}

struct Tensors { const bf16* GQ; const bf16* GK; const bf16* GV; const bf16* GR; const float* GLR; const float* WA; const float* BA; const float* GN; bf16* ST; float* DEC; bf16* OA; bf16* KF; bf16* QF; };

__device__ __forceinline__ void unit_a(const Tensors& X, int b, int hh, int c, LAS unsigned char* lds) {
    const int tid = threadIdx.x, w = __builtin_amdgcn_readfirstlane(tid >> 6), lane = tid & 63, r = lane & 31, h = lane >> 5, pt = w & 3, dh = w >> 2;
    const size_t row0 = (size_t)b * SEQ + (size_t)c * CH, row = row0 + 32 * pt + r;
    const size_t unit_id = (size_t)(b * GLA_H + hh) * NCH + c;
#pragma unroll
    for (int i = 0; i < 8; ++i) { const int piece = tid + 512 * i, ri = piece >> 5, cj = piece & 31;
        const u32x4 v = *reinterpret_cast<const u32x4*>(X.GV + (row0 + ri) * 1024 + hh * 256 + cj * 8);
        *reinterpret_cast<LAS u32x4*>(lds + L_V + ri * VSTR + cj * 16) = v; }
    const int T0 = 2 * dh;
    u32x2 kw[2][4], qw[2][4];
#pragma unroll
    for (int t = 0; t < 2; ++t)
#pragma unroll
        for (int g = 0; g < 4; ++g) { const int ch0 = 32 * (T0 + t) + 8 * g + 4 * h;
            const size_t gi = ((size_t)((row >> 5) * 128 + ((hh * 128 + ch0) >> 2)) * 32 + (row & 31)) * 4;
            kw[t][g] = *reinterpret_cast<const u32x2*>(X.GK + gi); qw[t][g] = *reinterpret_cast<const u32x2*>(X.GQ + gi); }
    float xb[2][16];
    {
        const f32x4 g0 = *reinterpret_cast<const f32x4*>(X.GLR + row * 16 + 8 * h), g1 = *reinterpret_cast<const f32x4*>(X.GLR + row * 16 + 8 * h + 4);
        float wv[2][8]; f32x4 bb[2][4];
#pragma unroll
        for (int t = 0; t < 2; ++t) {
#pragma unroll
            for (int j = 0; j < 8; ++j) wv[t][j] = X.WA[(8 * h + j) * 512 + hh * 128 + 32 * (T0 + t) + r];
#pragma unroll
            for (int g = 0; g < 4; ++g) bb[t][g] = *reinterpret_cast<const f32x4*>(X.BA + hh * 128 + 32 * (T0 + t) + 8 * g + 4 * h); }
        const float gv[8] = {g0.x, g0.y, g0.z, g0.w, g1.x, g1.y, g1.z, g1.w}; float gh[8], gl[8];
#pragma unroll
        for (int j = 0; j < 8; ++j) { gh[j] = bfround(gv[j]); gl[j] = gv[j] - gh[j]; }
        const bf16x8 Bhi = pack8(gh), Blo = pack8(gl);
#pragma unroll
        for (int t = 0; t < 2; ++t) {
            float wh[8], wl[8];
#pragma unroll
            for (int j = 0; j < 8; ++j) { wh[j] = bfround(wv[t][j]); wl[j] = wv[t][j] - wh[j]; }
            const bf16x8 Ahi = pack8(wh), Alo = pack8(wl);
            f32x16 xt = {};
            xt = __builtin_amdgcn_mfma_f32_32x32x16_bf16(Ahi, Bhi, xt, 0, 0, 0);
            xt = __builtin_amdgcn_mfma_f32_32x32x16_bf16(Alo, Bhi, xt, 0, 0, 0);
            xt = __builtin_amdgcn_mfma_f32_32x32x16_bf16(Ahi, Blo, xt, 0, 0, 0);
#pragma unroll
            for (int g = 0; g < 4; ++g)
#pragma unroll
                for (int e = 0; e < 4; ++e) { const float xv = xt[4 * g + e] + bb[t][g][e];
                    const float ee = __builtin_amdgcn_exp2f(-fabsf(xv) * LOG2E); const float ls = fminf(xv, 0.f) - __builtin_amdgcn_logf(1.0f + ee) * LN2;
                    xb[t][4 * g + e] = scan32(ls * 0.0625f); }
        }
    }
    LAS float* tot = (LAS float*)(lds + L_TOT); LAS float* pre = (LAS float*)(lds + L_PRE); LAS float* eB = (LAS float*)(lds + L_EB);
    if (r == 31) {
#pragma unroll
        for (int t = 0; t < 2; ++t)
#pragma unroll
            for (int i = 0; i < 16; ++i) tot[pt * 128 + 32 * (T0 + t) + crow(i, h)] = xb[t][i];
    }
    __syncthreads();
    if (tid < 128) { float p = 0.f;
#pragma unroll
        for (int t = 0; t < 4; ++t) { pre[t * 128 + tid] = p; p += tot[t * 128 + tid]; }
        const float e = __builtin_amdgcn_exp2f(p * LOG2E); eB[tid] = e;
        X.DEC[unit_id * 128 + tid] = e; }
    __syncthreads();
    unsigned char* kfg = (unsigned char*)X.KF + unit_id * 32768; unsigned char* qfg = (unsigned char*)X.QF + unit_id * 32768;
#pragma unroll
    for (int t = 0; t < 2; ++t) { const int T = T0 + t; float kt[16], qt[16];
#pragma unroll
        for (int g = 0; g < 4; ++g) { const int ch0 = 32 * T + 8 * g + 4 * h;
            const f32x4 pp = *reinterpret_cast<const LAS f32x4*>(pre + pt * 128 + ch0);
            const float kv[4] = {pg8::bf_lo(kw[t][g].x), pg8::bf_hi(kw[t][g].x), pg8::bf_lo(kw[t][g].y), pg8::bf_hi(kw[t][g].y)};
            const float qv[4] = {pg8::bf_lo(qw[t][g].x), pg8::bf_hi(qw[t][g].x), pg8::bf_lo(qw[t][g].y), pg8::bf_hi(qw[t][g].y)};
#pragma unroll
            for (int e = 0; e < 4; ++e) { const float bbv = (xb[t][4 * g + e] + pp[e]) * LOG2E;
                kt[4 * g + e] = kv[e] * __builtin_amdgcn_exp2f(-bbv); qt[4 * g + e] = qv[e] * __builtin_amdgcn_exp2f(bbv) * DKS; }
            u32x2 o; o.x = cvtpk(kt[4 * g], kt[4 * g + 1]); o.y = cvtpk(kt[4 * g + 2], kt[4 * g + 3]);
            *reinterpret_cast<LAS u32x2*>(lds + L_K + (32 * pt + r) * KSTR + ch0 * 2) = o;
        }
        *reinterpret_cast<bf16x8*>(kfg + ((pt * 8 + 2 * T) * 64 + lane) * 16) = pack8(kt); *reinterpret_cast<bf16x8*>(kfg + ((pt * 8 + 2 * T + 1) * 64 + lane) * 16) = pack8(kt + 8);
        *reinterpret_cast<bf16x8*>(qfg + ((pt * 8 + 2 * T) * 64 + lane) * 16) = pack8(qt); *reinterpret_cast<bf16x8*>(qfg + ((pt * 8 + 2 * T + 1) * 64 + lane) * 16) = pack8(qt + 8);
    }
    __syncthreads();
    const int q4 = (lane & 15) >> 2, p4 = lane & 3, rhalf = (lane >> 4) & 1;
    const int d = w;
    f32x16 acc[4] = {};
    const int vbase = (int)(uintptr_t)(lds + L_V) + (8 * h + q4) * VSTR + (32 * d + 16 * rhalf + 4 * p4) * 2;
    const int kbase = (int)(uintptr_t)(lds + L_K) + (8 * h + q4) * KSTR + (16 * rhalf + 4 * p4) * 2;
    {
#define GLA_AR(s2_, v0, v1, k00, k01, k02, k03, k10, k11, k12, k13) \
        const s16x4 v0 = tr_read(vbase + (16 * (s2_)) * VSTR), v1 = tr_read(vbase + (16 * (s2_) + 4) * VSTR), \
                    k00 = tr_read(kbase + (16 * (s2_)) * KSTR), k01 = tr_read(kbase + (16 * (s2_)) * KSTR + 64), k02 = tr_read(kbase + (16 * (s2_)) * KSTR + 128), k03 = tr_read(kbase + (16 * (s2_)) * KSTR + 192), \
                    k10 = tr_read(kbase + (16 * (s2_) + 4) * KSTR), k11 = tr_read(kbase + (16 * (s2_) + 4) * KSTR + 64), k12 = tr_read(kbase + (16 * (s2_) + 4) * KSTR + 128), k13 = tr_read(kbase + (16 * (s2_) + 4) * KSTR + 192)
#define GLA_AM(v0, v1, k00, k01, k02, k03, k10, k11, k12, k13) do { const bf16x8 Bv = GLA_PK(v0, v1); \
        acc[0] = __builtin_amdgcn_mfma_f32_32x32x16_bf16(GLA_PK(k00, k10), Bv, acc[0], 0, 0, 0); acc[1] = __builtin_amdgcn_mfma_f32_32x32x16_bf16(GLA_PK(k01, k11), Bv, acc[1], 0, 0, 0); \
        acc[2] = __builtin_amdgcn_mfma_f32_32x32x16_bf16(GLA_PK(k02, k12), Bv, acc[2], 0, 0, 0); acc[3] = __builtin_amdgcn_mfma_f32_32x32x16_bf16(GLA_PK(k03, k13), Bv, acc[3], 0, 0, 0); } while (0)
#define GLA_CW(n) do { asm volatile("s_waitcnt lgkmcnt(" #n ")" ::: "memory"); __builtin_amdgcn_sched_barrier(0); } while (0)
        GLA_AR(0, p0, p1, p2, p3, p4, p5, p6, p7, p8, p9);
        GLA_AR(1, q0, q1, q2, q3, q4_, q5, q6, q7, q8, q9);   GLA_CW(10); GLA_AM(p0, p1, p2, p3, p4, p5, p6, p7, p8, p9);
        GLA_AR(2, r0, r1, r2, r3, r4, r5, r6, r7, r8, r9);    GLA_CW(10); GLA_AM(q0, q1, q2, q3, q4_, q5, q6, q7, q8, q9);
        GLA_AR(3, s0, s1, s2, s3, s4, s5, s6, s7, s8, s9);    GLA_CW(10); GLA_AM(r0, r1, r2, r3, r4, r5, r6, r7, r8, r9);
        GLA_AR(4, t0, t1, t2_, t3, t4, t5, t6, t7, t8, t9);   GLA_CW(10); GLA_AM(s0, s1, s2, s3, s4, s5, s6, s7, s8, s9);
        GLA_AR(5, u0, u1, u2, u3, u4, u5, u6, u7, u8, u9);    GLA_CW(10); GLA_AM(t0, t1, t2_, t3, t4, t5, t6, t7, t8, t9);
        GLA_AR(6, w0, w1, w2, w3, w4, w5, w6, w7, w8, w9);    GLA_CW(10); GLA_AM(u0, u1, u2, u3, u4, u5, u6, u7, u8, u9);
        GLA_AR(7, x0, x1, x2, x3, x4, x5, x6, x7, x8, x9);    GLA_CW(10); GLA_AM(w0, w1, w2, w3, w4, w5, w6, w7, w8, w9);
        GLA_CW(0); GLA_AM(x0, x1, x2, x3, x4, x5, x6, x7, x8, x9);
#undef GLA_AR
#undef GLA_AM
#undef GLA_CW
    }
    unsigned char* Lg = (unsigned char*)X.ST + unit_id * 65536;
#pragma unroll
    for (int T = 0; T < 4; ++T) { float o[16];
#pragma unroll
        for (int g = 0; g < 4; ++g) { const f32x4 sc = *reinterpret_cast<const LAS f32x4*>(eB + 32 * T + 8 * g + 4 * h);
#pragma unroll
            for (int e = 0; e < 4; ++e) o[4 * g + e] = acc[T][4 * g + e] * sc[e]; }
        *reinterpret_cast<bf16x8*>(Lg + (((d * 4 + T) * 2 + 0) * 64 + lane) * 16) = pack8(o);
        *reinterpret_cast<bf16x8*>(Lg + (((d * 4 + T) * 2 + 1) * 64 + lane) * 16) = pack8(o + 8); }
    __syncthreads();
}

__device__ __forceinline__ void unit_c(const Tensors& X, int b, int hh, int c, LAS unsigned char* lds) {
    const int tid = threadIdx.x, w = __builtin_amdgcn_readfirstlane(tid >> 6), lane = tid & 63, r = lane & 31, h = lane >> 5, pt = w & 3, dh = w >> 2;
    const size_t row0 = (size_t)b * SEQ + (size_t)c * CH, row = row0 + 32 * pt + r;
    const size_t unit_id = (size_t)(b * GLA_H + hh) * NCH + c;
#pragma unroll
    for (int i = 0; i < 8; ++i) { const int piece = tid + 512 * i, ri = piece >> 5, cj = piece & 31;
        const u32x4 v = *reinterpret_cast<const u32x4*>(X.GV + (row0 + ri) * 1024 + hh * 256 + cj * 8);
        *reinterpret_cast<LAS u32x4*>(lds + L_V + ri * VSTR + cj * 16) = v; }
    const unsigned char* kfg = (const unsigned char*)X.KF + unit_id * 32768; const unsigned char* qfg = (const unsigned char*)X.QF + unit_id * 32768;
    const unsigned char* Sg = (const unsigned char*)X.ST + unit_id * 65536;
    bf16x8 qf[8], kfa[8], kfb[8];
#pragma unroll
    for (int s = 0; s < 8; ++s) qf[s] = *reinterpret_cast<const bf16x8*>(qfg + ((pt * 8 + s) * 64 + lane) * 16);
#pragma unroll
    for (int s = 0; s < 8; ++s) kfa[s] = *reinterpret_cast<const bf16x8*>(kfg + ((0 * 8 + s) * 64 + lane) * 16);
    if (pt >= 1) {
#pragma unroll
        for (int s = 0; s < 8; ++s) kfb[s] = *reinterpret_cast<const bf16x8*>(kfg + ((1 * 8 + s) * 64 + lane) * 16); }
    f32x16 acc[4] = {};
#pragma unroll
    for (int dd = 0; dd < 4; ++dd) { const int d = 4 * dh + dd;
#pragma unroll
        for (int s = 0; s < 8; ++s) { const bf16x8 a = *reinterpret_cast<const bf16x8*>(Sg + ((d * 8 + s) * 64 + lane) * 16);
            acc[dd] = __builtin_amdgcn_mfma_f32_32x32x16_bf16(a, qf[s], acc[dd], 0, 0, 0); } }
    __syncthreads();
    const int q4 = (lane & 15) >> 2, p4 = lane & 3, rhalf = (lane >> 4) & 1;
    const int vbase = (int)(uintptr_t)(lds + L_V) + (4 * h + q4) * VSTR + (128 * dh + 16 * rhalf + 4 * p4) * 2;
    for (int t2 = 0; t2 <= pt; ++t2) {
        f32x16 st = {};
#pragma unroll
        for (int s = 0; s < 8; ++s) st = __builtin_amdgcn_mfma_f32_32x32x16_bf16(kfa[s], qf[s], st, 0, 0, 0);
#pragma unroll
        for (int s = 0; s < 8; ++s) kfa[s] = kfb[s];
        if (t2 + 2 <= pt) {
#pragma unroll
            for (int s = 0; s < 8; ++s) kfb[s] = *reinterpret_cast<const bf16x8*>(kfg + (((t2 + 2) * 8 + s) * 64 + lane) * 16); }
        if (t2 == pt) {
#pragma unroll
            for (int i = 0; i < 16; ++i) if (crow(i, h) > r) st[i] = 0.f; }
        float sv[16];
#pragma unroll
        for (int i = 0; i < 16; ++i) sv[i] = st[i];
        const bf16x8 P0 = pack8(sv), P1 = pack8(sv + 8);
        {
            const int vb = vbase + (32 * t2) * VSTR;
#define GLA_VR(dd, a0, a1, a2, a3) const s16x4 a0 = tr_read(vb + 64 * (dd)), a1 = tr_read(vb + 64 * (dd) + 8 * VSTR), a2 = tr_read(vb + 64 * (dd) + 16 * VSTR), a3 = tr_read(vb + 64 * (dd) + 24 * VSTR)
#define GLA_VM(dd, a0, a1, a2, a3) do { acc[dd] = __builtin_amdgcn_mfma_f32_32x32x16_bf16(GLA_PK(a0, a1), P0, acc[dd], 0, 0, 0); acc[dd] = __builtin_amdgcn_mfma_f32_32x32x16_bf16(GLA_PK(a2, a3), P1, acc[dd], 0, 0, 0); } while (0)
#define GLA_CW(n) do { asm volatile("s_waitcnt lgkmcnt(" #n ")" ::: "memory"); __builtin_amdgcn_sched_barrier(0); } while (0)
            GLA_VR(0, e0, e1, e2, e3); GLA_VR(1, f0, f1, f2, f3);
            GLA_CW(4); GLA_VM(0, e0, e1, e2, e3);
            GLA_VR(2, g0, g1, g2, g3);
            GLA_CW(4); GLA_VM(1, f0, f1, f2, f3);
            GLA_VR(3, h0, h1, h2, h3);
            GLA_CW(4); GLA_VM(2, g0, g1, g2, g3);
            GLA_CW(0); GLA_VM(3, h0, h1, h2, h3);
#undef GLA_VR
#undef GLA_VM
#undef GLA_CW
        }
    }
    u32x2 grv[4][4];
#pragma unroll
    for (int dd = 0; dd < 4; ++dd)
#pragma unroll
        for (int g = 0; g < 4; ++g) { const int dv = 128 * dh + 32 * dd + 8 * g + 4 * h;
            grv[dd][g] = *reinterpret_cast<const u32x2*>(X.GR + ((size_t)((row >> 5) * 256 + ((hh * 256 + dv) >> 2)) * 32 + (row & 31)) * 4); }
    float ss = 0.f;
#pragma unroll
    for (int dd = 0; dd < 4; ++dd)
#pragma unroll
        for (int i = 0; i < 16; ++i) ss += acc[dd][i] * acc[dd][i];
    ss += __shfl_xor(ss, 32);
    LAS float* SS = (LAS float*)(lds + L_SS);
    if (h == 0) SS[(pt * 2 + dh) * 32 + r] = ss;
    __syncthreads();
    const float rs = 1.0f / sqrtf((SS[(pt * 2) * 32 + r] + SS[(pt * 2 + 1) * 32 + r]) * (1.0f / 256.0f) + NORM_EPS);
#pragma unroll
    for (int dd = 0; dd < 4; ++dd)
#pragma unroll
        for (int g = 0; g < 4; ++g) { const int dv = 128 * dh + 32 * dd + 8 * g + 4 * h;
            const f32x4 gn = *reinterpret_cast<const f32x4*>(X.GN + dv);
            const u32x2 gr = grv[dd][g];
            const float o0 = acc[dd][4 * g] * rs * gn.x * pg8::bf_lo(gr.x), o1 = acc[dd][4 * g + 1] * rs * gn.y * pg8::bf_hi(gr.x);
            const float o2 = acc[dd][4 * g + 2] * rs * gn.z * pg8::bf_lo(gr.y), o3 = acc[dd][4 * g + 3] * rs * gn.w * pg8::bf_hi(gr.y);
            u32x2 o; o.x = cvtpk(o0, o1); o.y = cvtpk(o2, o3);
            *reinterpret_cast<u32x2*>((unsigned char*)X.OA + pg8::tiled_off((int)row, hh * 256 + dv, 1024)) = o; }
    __syncthreads();
}
}

template <bool PASS_C>
__device__ __forceinline__ void gla_pass(Frame& F, const gla::Tensors& X) {
    for (int u = F.vcu; u < BATCH * GLA_H * gla::NCH; u += F.G) { if (PASS_C) gla::unit_c(X, u >> 8, (u >> 6) & 3, u & 63, F.lds + RING_OFF); else gla::unit_a(X, u >> 8, (u >> 6) & 3, u & 63, F.lds + RING_OFF); }
}
__device__ __forceinline__ void gla_scan(Frame& F, const gla::Tensors& X) {
    using gla::u32x2;
    const int gt = F.vcu * (NWAVES * 64) + F.tid;
    for (int e = gt; e < BATCH * GLA_H * 8192; e += F.G * NWAVES * 64) {
        const int bh = e >> 13, hp = e & 8191, piece = hp >> 1, j4 = hp & 1, lane = piece & 63, pu = piece >> 6, u = pu & 1, T = (pu >> 1) & 3;
        const int ch0 = 32 * T + 16 * u + 4 * (lane >> 5) + 8 * j4;
        unsigned char* base = (unsigned char*)X.ST + (size_t)bh * gla::NCH * 65536 + (size_t)piece * 16 + j4 * 8;
        const float* dec = X.DEC + (size_t)bh * gla::NCH * 128 + ch0;
        float s0 = 0.f, s1 = 0.f, s2 = 0.f, s3 = 0.f;
#pragma unroll 8
        for (int c = 0; c < gla::NCH; ++c) {
            const u32x2 l = *reinterpret_cast<const u32x2*>(base + (size_t)c * 65536);
            const f32x4 dc = *reinterpret_cast<const f32x4*>(dec + c * 128);
            u32x2 o; o.x = gla::cvtpk(s0, s1); o.y = gla::cvtpk(s2, s3);
            *reinterpret_cast<u32x2*>(base + (size_t)c * 65536) = o;
            s0 = fmaf(dc.x, s0, pg8::bf_lo(l.x)); s1 = fmaf(dc.y, s1, pg8::bf_hi(l.x)); s2 = fmaf(dc.z, s2, pg8::bf_lo(l.y)); s3 = fmaf(dc.w, s3, pg8::bf_hi(l.y));
        }
    }
}

namespace moba {
using bf16x8 = __attribute__((ext_vector_type(8))) short;
using s16x4  = __attribute__((ext_vector_type(4))) short;
using f32x16 = __attribute__((ext_vector_type(16))) float;
using u32x4  = __attribute__((ext_vector_type(4))) unsigned;
constexpr int D = 128, NW = 8, QBLK = 32, KVBLK = 64, LDQ = 1024, LDK = 1024, LDO = 1024;
constexpr float SCALE = 0.088388347648318440f, LOG2E = 1.4426950408889634f, C = SCALE * LOG2E;
constexpr int SDEPTH = 1;
constexpr float THRL = 8.f * LOG2E;
constexpr size_t SHM_V = KVBLK * D * 2, SHM_K = KVBLK * D * 2, SHM_Q = 2 * SHM_V + 2 * SHM_K + NW * 64 * 4, SHM_ATTN = SHM_Q + 65536;
#define KSWZ(row, colB) ((row) * 256 + ((colB) ^ (((row) & 7) << 4)))
#define SBAR() __builtin_amdgcn_sched_barrier(0)
__device__ __forceinline__ int crow(int r, int hi) { return (r & 3) + 8 * (r >> 2) + 4 * hi; }
__device__ __forceinline__ unsigned cvtpk(float lo, float hi) { unsigned r; asm volatile("v_cvt_pk_bf16_f32 %0, %1, %2" : "=v"(r) : "v"(lo), "v"(hi)); return r; }

__device__ __forceinline__ void bias_init(f32x16& p0, f32x16& p1, float lbc, float sl2c) {
#pragma unroll
  for (int r = 0; r < 16; ++r) { const int cr = (r & 3) + 8 * (r >> 2); p0[r] = fmaf(sl2c, (float)cr, lbc); p1[r] = fmaf(sl2c, (float)(cr + 32), lbc); }
}
template <bool CAUSAL>
__device__ __forceinline__ void partialSM(f32x16& p0, f32x16& p1, float& m_reg, float& mn, float& alpha, int dk) {
  if (CAUSAL) {
#pragma unroll
    for (int r = 0; r < 16; ++r) { const int cr = (r & 3) + 8 * (r >> 2); if (cr + dk > 0) p0[r] = -INFINITY; if (cr + 32 + dk > 0) p1[r] = -INFINITY; } }
  float pmax = p0[0];
#pragma unroll
  for (int r = 1; r < 16; ++r) pmax = fmaxf(pmax, p0[r]);
#pragma unroll
  for (int r = 0; r < 16; ++r) pmax = fmaxf(pmax, p1[r]);
  { auto rr = __builtin_amdgcn_permlane32_swap(__float_as_uint(pmax), __float_as_uint(pmax), false, false);
    pmax = fmaxf(__uint_as_float(rr[0]), __uint_as_float(rr[1])); }
  if (__builtin_expect(__all(pmax - m_reg <= THRL / C), 1)) { mn = m_reg; alpha = 1.f; }
  else { mn = fmaxf(m_reg, pmax); alpha = __builtin_amdgcn_exp2f((m_reg - mn) * C); m_reg = mn; }
  const float mnC = -mn * C;
#pragma unroll
  for (int r = 0; r < 16; ++r) { p0[r] = __builtin_amdgcn_exp2f(fmaf(p0[r], C, mnC)); p1[r] = fmaf(p1[r], C, mnC); }
}
__device__ __forceinline__ void finishSM(f32x16& p0, f32x16& p1, float alpha, float& l_reg, bf16x8& pa0, bf16x8& pa1, bf16x8& pa2, bf16x8& pa3) {
#pragma unroll
  for (int r = 0; r < 16; ++r) p1[r] = __builtin_amdgcn_exp2f(p1[r]);
  float ps = 0;
#pragma unroll
  for (int r = 0; r < 16; ++r) ps += p0[r];
#pragma unroll
  for (int r = 0; r < 16; ++r) ps += p1[r];
  { auto rr = __builtin_amdgcn_permlane32_swap(__float_as_uint(ps), __float_as_uint(ps), false, false);
    ps = __uint_as_float(rr[0]) + __uint_as_float(rr[1]); }
  l_reg = l_reg * alpha + ps;
#define PK4(P, BASE, OUT) do { unsigned a0 = cvtpk(P[BASE + 0], P[BASE + 1]), a1 = cvtpk(P[BASE + 2], P[BASE + 3]);   \
    unsigned b0 = cvtpk(P[BASE + 4], P[BASE + 5]), b1 = cvtpk(P[BASE + 6], P[BASE + 7]);                              \
    auto r0 = __builtin_amdgcn_permlane32_swap(a0, b0, false, false); auto r1 = __builtin_amdgcn_permlane32_swap(a1, b1, false, false); \
    u32x4 w = {r0[0], r1[0], r0[1], r1[1]}; OUT = *reinterpret_cast<bf16x8*>(&w); } while (0)
  PK4(p0, 0, pa0); PK4(p0, 8, pa1); PK4(p1, 0, pa2); PK4(p1, 8, pa3);
#undef PK4
}
__device__ __forceinline__ void qkt(f32x16& p0, f32x16& p1, const LAS unsigned char* Ks, const LAS unsigned char* qf, int r32, int hi) {
#pragma unroll
  for (int d0 = 0; d0 < 8; ++d0) { int cb = (d0 * 16 + hi * 8) * 2;
    bf16x8 b0 = *reinterpret_cast<const LAS bf16x8*>(Ks + KSWZ(r32, cb));
    bf16x8 b1 = *reinterpret_cast<const LAS bf16x8*>(Ks + KSWZ(32 + r32, cb));
    bf16x8 q = *reinterpret_cast<const LAS bf16x8*>(qf + d0 * 1024);
    p0 = __builtin_amdgcn_mfma_f32_32x32x16_bf16(b0, q, p0, 0, 0, 0);
    p1 = __builtin_amdgcn_mfma_f32_32x32x16_bf16(b1, q, p1, 0, 0, 0); }
}
__device__ __forceinline__ int v_st(int k, int c) { const int kk = (k & ~0xC) | ((k & 4) << 1) | ((k & 8) >> 1); return ((kk >> 3) * 4 + (c >> 5)) * 512 + ((kk & 7) * 32 + (c & 31)) * 2; }
__device__ __forceinline__ int v_rd_base(int lane) { return ((lane & 3) << 3) | (((lane >> 2) & 3) << 6) | (((lane >> 4) & 1) << 5) | (((lane >> 5) & 1) << 8); }
constexpr int v_rd_off(int d0, int ks, int half) { return d0 * 512 + ks * 4096 + half * 2048; }
template <int OFF> __device__ __forceinline__ s16x4 tr_read(int vb) {
  s16x4 r; asm volatile("ds_read_b64_tr_b16 %0, %1 offset:%2" : "=&v"(r) : "v"(vb), "i"(OFF) : "memory"); return r;
}
#define PV_READS(D0, l0, h0, l1, h1, l2, h2, l3, h3) \
  const s16x4 l0 = tr_read<v_rd_off(D0, 0, 0)>(vb), h0 = tr_read<v_rd_off(D0, 0, 1)>(vb), l1 = tr_read<v_rd_off(D0, 1, 0)>(vb), h1 = tr_read<v_rd_off(D0, 1, 1)>(vb), \
              l2 = tr_read<v_rd_off(D0, 2, 0)>(vb), h2 = tr_read<v_rd_off(D0, 2, 1)>(vb), l3 = tr_read<v_rd_off(D0, 3, 0)>(vb), h3 = tr_read<v_rd_off(D0, 3, 1)>(vb)
#define PV_PK(L, H) (bf16x8){L[0], L[1], L[2], L[3], H[0], H[1], H[2], H[3]}
#define PV_MMA(od, l0, h0, l1, h1, l2, h2, l3, h3) do { \
  od = __builtin_amdgcn_mfma_f32_32x32x16_bf16(pa0, PV_PK(l0, h0), od, 0, 0, 0); od = __builtin_amdgcn_mfma_f32_32x32x16_bf16(pa1, PV_PK(l1, h1), od, 0, 0, 0); \
  od = __builtin_amdgcn_mfma_f32_32x32x16_bf16(pa2, PV_PK(l2, h2), od, 0, 0, 0); od = __builtin_amdgcn_mfma_f32_32x32x16_bf16(pa3, PV_PK(l3, h3), od, 0, 0, 0); } while (0)
__device__ __forceinline__ void pv_d0(f32x16* o, int vb, bf16x8 pa0, bf16x8 pa1, bf16x8 pa2, bf16x8 pa3) {
  PV_READS(0, a0, a1, a2, a3, a4, a5, a6, a7);
  PV_READS(1, b0, b1, b2, b3, b4, b5, b6, b7);
  asm volatile("s_waitcnt lgkmcnt(8)" ::: "memory"); SBAR();
  PV_MMA(o[0], a0, a1, a2, a3, a4, a5, a6, a7);
  PV_READS(2, c0, c1, c2, c3, c4, c5, c6, c7);
  asm volatile("s_waitcnt lgkmcnt(8)" ::: "memory"); SBAR();
  PV_MMA(o[1], b0, b1, b2, b3, b4, b5, b6, b7);
  PV_READS(3, d0, d1, d2, d3, d4, d5, d6, d7);
  asm volatile("s_waitcnt lgkmcnt(8)" ::: "memory"); SBAR();
  PV_MMA(o[2], c0, c1, c2, c3, c4, c5, c6, c7);
  asm volatile("s_waitcnt lgkmcnt(0)" ::: "memory"); SBAR();
  PV_MMA(o[3], d0, d1, d2, d3, d4, d5, d6, d7);
}
#undef PV_READS
#undef PV_PK
#undef PV_MMA

template <int D0> __device__ __forceinline__ void pv_one_lite(f32x16& od, int vb, bf16x8 pa0, bf16x8 pa1, bf16x8 pa2, bf16x8 pa3) {
  const s16x4 l0 = tr_read<v_rd_off(D0, 0, 0)>(vb), h0 = tr_read<v_rd_off(D0, 0, 1)>(vb), l1 = tr_read<v_rd_off(D0, 1, 0)>(vb), h1 = tr_read<v_rd_off(D0, 1, 1)>(vb);
  const s16x4 l2 = tr_read<v_rd_off(D0, 2, 0)>(vb), h2 = tr_read<v_rd_off(D0, 2, 1)>(vb), l3 = tr_read<v_rd_off(D0, 3, 0)>(vb), h3 = tr_read<v_rd_off(D0, 3, 1)>(vb);
  asm volatile("s_waitcnt lgkmcnt(0)" ::: "memory"); SBAR();
#define PK(L, H) (bf16x8){L[0], L[1], L[2], L[3], H[0], H[1], H[2], H[3]}
  od = __builtin_amdgcn_mfma_f32_32x32x16_bf16(pa0, PK(l0, h0), od, 0, 0, 0);
  od = __builtin_amdgcn_mfma_f32_32x32x16_bf16(pa1, PK(l1, h1), od, 0, 0, 0);
  od = __builtin_amdgcn_mfma_f32_32x32x16_bf16(pa2, PK(l2, h2), od, 0, 0, 0);
  od = __builtin_amdgcn_mfma_f32_32x32x16_bf16(pa3, PK(l3, h3), od, 0, 0, 0);
#undef PK
}
__device__ __forceinline__ void pv_d0_lite(f32x16* o, int vb, bf16x8 pa0, bf16x8 pa1, bf16x8 pa2, bf16x8 pa3) {
  pv_one_lite<0>(o[0], vb, pa0, pa1, pa2, pa3); pv_one_lite<1>(o[1], vb, pa0, pa1, pa2, pa3); pv_one_lite<2>(o[2], vb, pa0, pa1, pa2, pa3); pv_one_lite<3>(o[3], vb, pa0, pa1, pa2, pa3);
}

struct PartBufs { bf16* po; float* pm; float* pl; };
__device__ __forceinline__ size_t slot_off(int slot) { return slot == 0 ? (size_t)0 : (slot == 1 ? (size_t)(R1_GV / 2) : (size_t)((WS_GLAS - WS_R1) / 2)); }
__device__ __forceinline__ void unit(const bf16* __restrict__ Qb, const bf16* __restrict__ Kh, const bf16* __restrict__ Vh, bf16* __restrict__ Ob,
                                     const unsigned* __restrict__ selrow, const PartBufs& PB, size_t prow0, int qi, float sl2, LAS unsigned char* lds, int orow0, int ocol0) {
  const int tid = threadIdx.x, wid = tid >> 6, lane = tid & 63, r32 = lane & 31, hi = lane >> 5;
  LAS unsigned char* V_lds = lds; LAS unsigned char* K_lds = lds + 2 * SHM_V;
  LAS float* ws = (LAS float*)(lds + 2 * SHM_V + 2 * SHM_K) + wid * 64; LAS float* li_l = ws; LAS float* al_l = ws + 32;
  float m_reg = -1e30f, l_reg = 0; f32x16 o[4] = {};
  LAS unsigned char* qr = lds + SHM_Q + wid * 8192 + lane * 16;
  const int qrel = wid * QBLK + r32, tq = qi * 256 + qrel;
  const bf16* Qw = Qb + (long)qrel * LDQ + hi * 8;
#pragma unroll
  for (int d0 = 0; d0 < 8; ++d0) *reinterpret_cast<LAS bf16x8*>(qr + d0 * 1024) = *reinterpret_cast<const bf16x8*>(Qw + d0 * 16);
  const int sr = tid >> 4, sc = (tid & 15) * 8, vst0 = v_st(sr, sc), vst1 = v_st(32 + sr, sc);
  const int vb0 = (int)(uintptr_t)V_lds + v_rd_base(lane);
  struct { bf16x8 vs0, vs1, ks0, ks1; } sr_[SDEPTH];
  constexpr int NT = 4;
#define KT(t) (4 * qi + (t))
#define SLOAD(i, t) do { const int k0_ = KT(t) * KVBLK; sr_[i].vs0 = *reinterpret_cast<const bf16x8*>(&Vh[(long)(k0_ + sr) * LDK + sc]); sr_[i].vs1 = *reinterpret_cast<const bf16x8*>(&Vh[(long)(k0_ + 32 + sr) * LDK + sc]); \
    sr_[i].ks0 = *reinterpret_cast<const bf16x8*>(&Kh[(long)(k0_ + sr) * LDK + sc]); sr_[i].ks1 = *reinterpret_cast<const bf16x8*>(&Kh[(long)(k0_ + 32 + sr) * LDK + sc]); } while (0)
#define SWRITE(b, i) do { *(LAS bf16x8*)(V_lds + (b) * SHM_V + vst0) = sr_[i].vs0;          \
    *(LAS bf16x8*)(V_lds + (b) * SHM_V + vst1) = sr_[i].vs1; int kc = sc * 2;               \
    *(LAS bf16x8*)(K_lds + (b) * SHM_K + KSWZ(sr, kc)) = sr_[i].ks0;                       \
    *(LAS bf16x8*)(K_lds + (b) * SHM_K + KSWZ(32 + sr, kc)) = sr_[i].ks1; } while (0)
#define SWAIT() do { if (SDEPTH == 2) asm volatile("s_waitcnt vmcnt(4)" ::: "memory"); else asm volatile("s_waitcnt vmcnt(0)" ::: "memory"); } while (0)
#define RESC(a) do { if (__any((a) < 1.f)) { if (hi == 0) al_l[r32] = (a); asm volatile("s_waitcnt lgkmcnt(0)" ::: "memory"); \
    _Pragma("unroll") for (int d = 0; d < 4; ++d) _Pragma("unroll") for (int r = 0; r < 16; ++r) o[d][r] *= al_l[crow(r, hi)]; } } while (0)
#define PSM(P0, P1, MN, AL, t) do { const int dk_ = KT(t) * KVBLK + 4 * hi - tq; partialSM<true>(P0, P1, m_reg, MN, AL, dk_); } while (0)
#define QKT(P0, P1, KS, t) do { const int dk_ = KT(t) * KVBLK + 4 * hi - tq; bias_init(P0, P1, sl2c * (float)dk_, sl2c); qkt(P0, P1, KS, qr, r32, hi); } while (0)
  f32x16 pA0, pA1, pB0, pB1; float mnA, mnB, alA, alB; bf16x8 pa0, pa1, pa2, pa3;
  constexpr int SE = 0, SO = SDEPTH - 1;
  SLOAD(SE, 0); asm volatile("s_waitcnt vmcnt(0)" ::: "memory"); SWRITE(0, SE); __syncthreads();
  const float sl2c = sl2 * (1.0f / C);
  QKT(pA0, pA1, K_lds, 0); PSM(pA0, pA1, mnA, alA, 0);
  SLOAD(SO, 1); if (SDEPTH == 2) { if (2 < NT) SLOAD(SE, 2); }
  SWAIT(); SWRITE(1, SO); __syncthreads();
  for (int j = 1; j + 1 < NT; j += 2) {
    SBAR(); QKT(pB0, pB1, K_lds + SHM_K, j);
    finishSM(pA0, pA1, alA, l_reg, pa0, pa1, pa2, pa3); SBAR();
    SLOAD(SO, j + SDEPTH); SBAR();
    pv_d0(o, vb0, pa0, pa1, pa2, pa3); PSM(pB0, pB1, mnB, alB, j);
    __syncthreads(); SWAIT(); SWRITE(0, SE);
    RESC(alB); __syncthreads();
    SBAR(); QKT(pA0, pA1, K_lds, j + 1);
    finishSM(pB0, pB1, alB, l_reg, pa0, pa1, pa2, pa3); SBAR();
    if (SDEPTH == 1 || j + 3 < NT) SLOAD(SE, j + 1 + SDEPTH); SBAR();
    pv_d0(o, vb0 + (int)SHM_V, pa0, pa1, pa2, pa3); PSM(pA0, pA1, mnA, alA, j + 1);
    __syncthreads(); SWAIT(); SWRITE(1, SO);
    RESC(alA); __syncthreads();
  }
  SBAR(); QKT(pB0, pB1, K_lds + SHM_K, NT - 1);
  finishSM(pA0, pA1, alA, l_reg, pa0, pa1, pa2, pa3); SBAR();
  pv_d0(o, vb0, pa0, pa1, pa2, pa3); PSM(pB0, pB1, mnB, alB, NT - 1);
  __syncthreads(); RESC(alB);
  finishSM(pB0, pB1, alB, l_reg, pa0, pa1, pa2, pa3); SBAR();
  pv_d0(o, vb0 + (int)SHM_V, pa0, pa1, pa2, pa3);
  { int t2 = threadIdx.x; asm volatile("" : "+v"(t2));
    const int wid2 = t2 >> 6, lane2 = t2 & 63, r2 = lane2 & 31, hi2 = lane2 >> 5, qrel2 = wid2 * QBLK + r2;
    const unsigned selm2 = selrow[qrel2];
    const int nsel = __builtin_popcount(selm2); const size_t pq = prow0 + (size_t)qrel2;
    float mp[3], lp[3];
#pragma unroll
    for (int s_ = 0; s_ < 3; ++s_) { const bool ok = s_ < nsel; mp[s_] = ok ? PB.pm[(size_t)s_ * (32 * 8192) + pq] : -INFINITY; lp[s_] = ok ? PB.pl[(size_t)s_ * (32 * 8192) + pq] : 0.f; }
    const float mo = m_reg * C;
    const float Mx = fmaxf(fmaxf(mo, mp[0]), fmaxf(mp[1], mp[2]));
    const float wo = __builtin_amdgcn_exp2f(mo - Mx), w0 = lp[0] * __builtin_amdgcn_exp2f(mp[0] - Mx), w1 = lp[1] * __builtin_amdgcn_exp2f(mp[1] - Mx), w2 = lp[2] * __builtin_amdgcn_exp2f(mp[2] - Mx);
    const float rL = __builtin_amdgcn_rcpf(l_reg * wo + (w0 + w1 + w2));
    LAS float* mg = (LAS float*)(lds + SHM_Q + wid2 * 8192);
    if (hi2 == 0) { mg[r2] = wo * rL; mg[32 + r2] = w0 * rL; mg[64 + r2] = w1 * rL; mg[96 + r2] = w2 * rL; }
    asm volatile("s_waitcnt lgkmcnt(0)" ::: "memory");
#pragma unroll
    for (int r = 0; r < 16; ++r) { const int orow = crow(r, hi2);
      const float a = mg[orow], c0 = mg[32 + orow], c1 = mg[64 + orow], c2 = mg[96 + orow];
      const size_t pr = (prow0 + (size_t)(wid2 * QBLK + orow)) * 128 + r2;
      unsigned short q0[4], q1[4], q2[4];
#pragma unroll
      for (int d0 = 0; d0 < 4; ++d0) { q0[d0] = PB.po[slot_off(0) + pr + d0 * 32]; q1[d0] = PB.po[slot_off(1) + pr + d0 * 32]; q2[d0] = PB.po[slot_off(2) + pr + d0 * 32]; }
#pragma unroll
      for (int d0 = 0; d0 < 4; ++d0) { float v = o[d0][r] * a;
        const float f0 = fmaf(pg8::bf_lo((unsigned)q0[d0]), c0, v); v = c0 > 0.f ? f0 : v;
        const float f1 = fmaf(pg8::bf_lo((unsigned)q1[d0]), c1, v); v = c1 > 0.f ? f1 : v;
        const float f2 = fmaf(pg8::bf_lo((unsigned)q2[d0]), c2, v); v = c2 > 0.f ? f2 : v;
        *(bf16*)((unsigned char*)Ob + pg8::tiled_off(orow0 + wid2 * QBLK + orow, ocol0 + d0 * 32 + r2, 1024)) = (bf16)pg8::cvt_pk_bf16(v, 0.f); } } }
  __syncthreads();
#undef KT
#undef SLOAD
#undef SWRITE
#undef SWAIT
#undef RESC
#undef PSM
#undef QKT
}

constexpr int P_K = 0, P_V = 65536, P_LIST = 131072, P_GCNT = P_LIST + 15872, P_GOFF = P_GCNT + 512, P_TOT = P_GOFF + 512, P_BOX = P_TOT + 16, P_WS = P_BOX + 16, P_END = P_WS + NW * 256;
__device__ __forceinline__ void qkt_r(f32x16& p0, f32x16& p1, const LAS unsigned char* Ks, const bf16x8* qr, int r32, int hi) {
#pragma unroll
  for (int d0 = 0; d0 < 8; ++d0) { int cb = (d0 * 16 + hi * 8) * 2;
    bf16x8 b0 = *reinterpret_cast<const LAS bf16x8*>(Ks + KSWZ(r32, cb));
    bf16x8 b1 = *reinterpret_cast<const LAS bf16x8*>(Ks + KSWZ(32 + r32, cb));
    p0 = __builtin_amdgcn_mfma_f32_32x32x16_bf16(b0, qr[d0], p0, 0, 0, 0);
    p1 = __builtin_amdgcn_mfma_f32_32x32x16_bf16(b1, qr[d0], p1, 0, 0, 0); }
}
__device__ __forceinline__ void partial_unit(const bf16* __restrict__ MQ, const bf16* __restrict__ MK, const bf16* __restrict__ MV, const unsigned* __restrict__ SEL,
                                             const PartBufs& PB, int b, int h, int j, LAS unsigned char* lds) {
  const int tid = threadIdx.x, wid = __builtin_amdgcn_readfirstlane(tid >> 6), lane = tid & 63, r32 = lane & 31, hi = lane >> 5;
  const int bh = b * 8 + h, t0 = 256 * (j + 1), ngroups = 4 * (31 - j);
  const float sl2c = __builtin_amdgcn_exp2f(-(float)(h + 1)) * LOG2E * (1.0f / C);
  LAS unsigned* gcnt = (LAS unsigned*)(lds + P_GCNT); LAS unsigned* goff = (LAS unsigned*)(lds + P_GOFF); LAS unsigned* totp = (LAS unsigned*)(lds + P_TOT);
  LAS unsigned short* list = (LAS unsigned short*)(lds + P_LIST);
  const unsigned* selb = SEL + (size_t)bh * 8192 + t0;
  unsigned sw[16];
#pragma unroll
  for (int i = 0; i < 16; ++i) { const int g = wid + NW * i; sw[i] = g < ngroups ? selb[64 * g + lane] : 0u; }
  { const bf16* Kh = MK + ((size_t)b * 8192 + 256 * j) * LDK + h * 128; const bf16* Vh = MV + ((size_t)b * 8192 + 256 * j) * LDK + h * 128;
    const int sr = tid >> 4, sc = (tid & 15) * 8, vst0 = v_st(sr, sc), vst1 = v_st(32 + sr, sc), kc = sc * 2;
    bf16x8 kk[8], vv[8];
#pragma unroll
    for (int q = 0; q < 8; ++q) { const int row = (q >> 1) * 64 + (q & 1) * 32 + sr;
      kk[q] = *reinterpret_cast<const bf16x8*>(Kh + (size_t)row * LDK + sc); vv[q] = *reinterpret_cast<const bf16x8*>(Vh + (size_t)row * LDK + sc); }
#pragma unroll
    for (int q = 0; q < 8; ++q) { const int kt = q >> 1, rr = (q & 1) * 32 + sr;
      *(LAS bf16x8*)(lds + P_K + kt * 16384 + KSWZ(rr, kc)) = kk[q];
      *(LAS bf16x8*)(lds + P_V + kt * 16384 + ((q & 1) ? vst1 : vst0)) = vv[q]; } }
#pragma unroll
  for (int i = 0; i < 16; ++i) { const int g = wid + NW * i; const unsigned long long bal = __ballot((sw[i] >> j) & 1u);
    if (g < ngroups && lane == 0) gcnt[g] = (unsigned)__builtin_popcountll(bal); }
  __syncthreads();
  if (wid == 0) {
    const unsigned c0 = (2 * lane < ngroups) ? gcnt[2 * lane] : 0u, c1 = (2 * lane + 1 < ngroups) ? gcnt[2 * lane + 1] : 0u;
    unsigned x = c0 + c1;
#pragma unroll
    for (int o = 1; o < 64; o <<= 1) { const unsigned y = __shfl_up(x, o); if (lane >= o) x += y; }
    const unsigned ex = x - (c0 + c1);
    goff[2 * lane] = ex; goff[2 * lane + 1] = ex + c0;
    if (lane == 63) totp[0] = x; }
  __syncthreads();
#pragma unroll
  for (int i = 0; i < 16; ++i) { const int g = wid + NW * i; const bool pick = (sw[i] >> j) & 1u; const unsigned long long bal = __ballot(pick);
    const unsigned pos = __builtin_amdgcn_mbcnt_hi((unsigned)(bal >> 32), __builtin_amdgcn_mbcnt_lo((unsigned)bal, 0u));
    if (g < ngroups && pick) list[goff[g] + pos] = (unsigned short)((64 * g + lane) | (__builtin_popcount(sw[i] & ((1u << j) - 1u)) << 13)); }
  __syncthreads();
  const int total = (int)totp[0], ntiles = (total + 31) >> 5;
  LAS float* ws = (LAS float*)(lds + P_WS) + wid * 64; LAS float* li_l = ws; LAS float* al_l = ws + 32;
  const int vb0 = (int)(uintptr_t)(lds + P_V) + v_rd_base(lane);
#define LOADQ(E, Q, T) do { const int b_ = (T) * 32, v_ = (total - b_) < 32 ? (total - b_) : 32; E = list[b_ + (r32 < v_ ? r32 : v_ - 1)]; \
    const bf16* Qw_ = MQ + ((size_t)b * 8192 + t0 + (int)(E & 8191u)) * LDQ + h * 128 + hi * 8; \
    _Pragma("unroll") for (int d0 = 0; d0 < 8; ++d0) Q[d0] = *reinterpret_cast<const bf16x8*>(Qw_ + d0 * 16); } while (0)
  unsigned e = 0u; bf16x8 qr[8];
  if (wid < ntiles) LOADQ(e, qr, wid);
  for (int tile = wid; tile < ntiles; tile += NW) {
    const int base = tile * 32, valid = (total - base) < 32 ? (total - base) : 32;
    const int tq = t0 + (int)(e & 8191u);
    unsigned en = 0u;
    const bool more = tile + NW < ntiles;
    float m_reg = -1e30f, l_reg = 0.f; f32x16 o[4] = {};
    {
      f32x16 pA0, pA1, pB0, pB1; float mnA, mnB, alA, alB; bf16x8 pa0, pa1, pa2, pa3;
      const int dk0 = 256 * j + 4 * hi - tq;
#define PT_QK(P0, P1, kt) do { bias_init(P0, P1, sl2c * (float)(dk0 + 64 * (kt)), sl2c); qkt_r(P0, P1, lds + P_K + (kt) * 16384, qr, r32, hi); } while (0)
#define PT_RESC(a) do { if (__any((a) < 1.f)) { if (hi == 0) al_l[r32] = (a); asm volatile("s_waitcnt lgkmcnt(0)" ::: "memory"); \
        _Pragma("unroll") for (int d = 0; d < 4; ++d) _Pragma("unroll") for (int r = 0; r < 16; ++r) o[d][r] *= al_l[crow(r, hi)]; } } while (0)
      PT_QK(pA0, pA1, 0); partialSM<false>(pA0, pA1, m_reg, mnA, alA, dk0);
      PT_QK(pB0, pB1, 1); finishSM(pA0, pA1, alA, l_reg, pa0, pa1, pa2, pa3); SBAR();
      pv_d0_lite(o, vb0, pa0, pa1, pa2, pa3); partialSM<false>(pB0, pB1, m_reg, mnB, alB, dk0 + 64); PT_RESC(alB);
      PT_QK(pA0, pA1, 2); finishSM(pB0, pB1, alB, l_reg, pa0, pa1, pa2, pa3); SBAR();
      pv_d0_lite(o, vb0 + 16384, pa0, pa1, pa2, pa3); partialSM<false>(pA0, pA1, m_reg, mnA, alA, dk0 + 128); PT_RESC(alA);
      PT_QK(pB0, pB1, 3);
      if (more) LOADQ(en, qr, tile + NW);
      finishSM(pA0, pA1, alA, l_reg, pa0, pa1, pa2, pa3); SBAR();
      pv_d0_lite(o, vb0 + 2 * 16384, pa0, pa1, pa2, pa3); partialSM<false>(pB0, pB1, m_reg, mnB, alB, dk0 + 192); PT_RESC(alB);
      finishSM(pB0, pB1, alB, l_reg, pa0, pa1, pa2, pa3); SBAR();
      pv_d0_lite(o, vb0 + 3 * 16384, pa0, pa1, pa2, pa3);
#undef PT_QK
#undef PT_RESC
    }
    if (hi == 0) li_l[r32] = l_reg; asm volatile("s_waitcnt lgkmcnt(0)" ::: "memory");
    if (hi == 0 && r32 < valid) { const size_t pq = (size_t)(e >> 13) * (32 * 8192) + (size_t)bh * 8192 + tq; PB.pm[pq] = m_reg * C; PB.pl[pq] = l_reg; }
#pragma unroll
    for (int r = 0; r < 16; ++r) { const int orow = crow(r, hi);
      if (orow < valid) { const unsigned er = list[base + orow]; const float rl = __builtin_amdgcn_rcpf(li_l[orow]);
        bf16* dst = PB.po + slot_off((int)(er >> 13)) + ((size_t)bh * 8192 + t0 + (er & 8191u)) * 128 + r32;
#pragma unroll
        for (int d0 = 0; d0 < 4; ++d0) dst[d0 * 32] = (bf16)pg8::cvt_pk_bf16(o[d0][r] * rl, 0.f); } }
    if (more) e = en;
  }
#undef LOADQ
  __syncthreads();
}
#undef KSWZ
#undef SBAR
}

__device__ __forceinline__ void moba_kmean_phase(Frame& F, const bf16* MK, float* kmean) {
    LAS float* red = (LAS float*)(F.lds + RING_OFF);
    for (int u = F.vcu; u < BATCH * MOBA_NB * 2; u += F.G) {
        const int half = u & 1, bj = u >> 1;
        const int ct = F.tid & 63, rg = F.tid >> 6;
        const pg8::u32x4* src = (const pg8::u32x4*)(MK + (size_t)(bj * 256 + rg * 32) * 1024 + half * 512 + ct * 8);
        float s[8] = {0.f, 0.f, 0.f, 0.f, 0.f, 0.f, 0.f, 0.f};
#pragma unroll 16
        for (int r = 0; r < 32; ++r) { const pg8::u32x4 w = src[(size_t)r * 128];
            s[0] += pg8::bf_lo(w.x); s[1] += pg8::bf_hi(w.x); s[2] += pg8::bf_lo(w.y); s[3] += pg8::bf_hi(w.y); s[4] += pg8::bf_lo(w.z); s[5] += pg8::bf_hi(w.z); s[6] += pg8::bf_lo(w.w); s[7] += pg8::bf_hi(w.w); }
#pragma unroll
        for (int i = 0; i < 8; ++i) red[rg * 512 + ct * 8 + i] = s[i];
        __syncthreads();
        { const int c = F.tid; float t = 0.f;
#pragma unroll
          for (int g = 0; g < 8; ++g) t += red[g * 512 + c];
          kmean[(size_t)bj * 1024 + half * 512 + c] = t * (1.0f / 256.0f); }
        __syncthreads();
    }
}
__device__ __forceinline__ bool sel_better(float s, int j, float v, int i) { return s > v || (s == v && j < i); }
__device__ __forceinline__ void sel_insert(float s, int j, float& v0, int& i0, float& v1, int& i1, float& v2, int& i2) {
    const bool b0 = sel_better(s, j, v0, i0), b1 = sel_better(s, j, v1, i1), b2 = sel_better(s, j, v2, i2);
    v2 = b1 ? v1 : (b2 ? s : v2); i2 = b1 ? i1 : (b2 ? j : i2);
    v1 = b0 ? v0 : (b1 ? s : v1); i1 = b0 ? i0 : (b1 ? j : i1);
    v0 = b0 ? s : v0; i0 = b0 ? j : i0;
}
__device__ __forceinline__ void moba_select_phase(Frame& F, const bf16* MQ, const float* kmean, unsigned* sel) {
    const int qn = F.lane & 15, kg = F.lane >> 4;
    for (int u = F.vcu; u < BATCH * MOBA_NB * MOBA_H; u += F.G) {
        const int a_ = u & 7, bh_ = (u >> 3) & 31, k_ = u >> 8, qi = a_ + 8 * k_, h = bh_ & 7, b = bh_ >> 3;
        const size_t q0 = (size_t)b * SEQ + (size_t)qi * 256 + F.wave * 32;
        unsigned mask[2] = {0u, 0u};
        if (qi > 0) {
            moba::bf16x8 qf[2][4];
#pragma unroll
            for (int cg = 0; cg < 2; ++cg)
#pragma unroll
                for (int ks = 0; ks < 4; ++ks) qf[cg][ks] = *reinterpret_cast<const moba::bf16x8*>(MQ + (q0 + cg * 16 + qn) * 1024 + h * 128 + ks * 32 + kg * 8);
            f32x4 acc[2][2];
#pragma unroll
            for (int rg = 0; rg < 2; ++rg) { acc[rg][0] = (f32x4){0.f, 0.f, 0.f, 0.f}; acc[rg][1] = (f32x4){0.f, 0.f, 0.f, 0.f}; }
#pragma unroll
            for (int rg = 0; rg < 2; ++rg) {
                if (rg * 16 < qi) {
#pragma unroll
                    for (int ks = 0; ks < 4; ++ks) {
                        const float* kp = kmean + (size_t)(b * 32 + rg * 16 + qn) * 1024 + h * 128 + ks * 32 + kg * 8;
                        const f32x4 k0 = *reinterpret_cast<const f32x4*>(kp), k1 = *reinterpret_cast<const f32x4*>(kp + 4);
                        float kv[8] = {k0.x, k0.y, k0.z, k0.w, k1.x, k1.y, k1.z, k1.w};
                        unsigned t[3][4];
#pragma unroll
                        for (int p = 0; p < 3; ++p)
#pragma unroll
                            for (int e = 0; e < 4; ++e) { const unsigned w = pg8::cvt_pk_bf16(kv[2 * e], kv[2 * e + 1]); t[p][e] = w; kv[2 * e] -= pg8::bf_lo(w); kv[2 * e + 1] -= pg8::bf_hi(w); }
#pragma unroll
                        for (int p = 0; p < 3; ++p) { moba::u32x4 w = {t[p][0], t[p][1], t[p][2], t[p][3]}; const moba::bf16x8 af = *reinterpret_cast<moba::bf16x8*>(&w);
                            acc[rg][0] = __builtin_amdgcn_mfma_f32_16x16x32_bf16(af, qf[0][ks], acc[rg][0], 0, 0, 0);
                            acc[rg][1] = __builtin_amdgcn_mfma_f32_16x16x32_bf16(af, qf[1][ks], acc[rg][1], 0, 0, 0); }
                    }
                }
            }
#pragma unroll
            for (int cg = 0; cg < 2; ++cg) {
                float v0 = -INFINITY, v1 = -INFINITY, v2 = -INFINITY; int i0 = 64, i1 = 64, i2 = 64;
#pragma unroll
                for (int rg = 0; rg < 2; ++rg)
#pragma unroll
                    for (int r = 0; r < 4; ++r) { const int j = rg * 16 + kg * 4 + r; const bool ok = j < qi; sel_insert(ok ? acc[rg][cg][r] : -INFINITY, ok ? j : 64, v0, i0, v1, i1, v2, i2); }
#pragma unroll
                for (int o = 16; o < 64; o <<= 1) {
                    const float w0 = __shfl_xor(v0, o), w1 = __shfl_xor(v1, o), w2 = __shfl_xor(v2, o); const int j0 = __shfl_xor(i0, o), j1 = __shfl_xor(i1, o), j2 = __shfl_xor(i2, o);
                    sel_insert(w0, j0, v0, i0, v1, i1, v2, i2); sel_insert(w1, j1, v0, i0, v1, i1, v2, i2); sel_insert(w2, j2, v0, i0, v1, i1, v2, i2); }
                mask[cg] = (i0 < 32 ? 1u << i0 : 0u) | (i1 < 32 ? 1u << i1 : 0u) | (i2 < 32 ? 1u << i2 : 0u);
            }
        }
        if (kg < 2) sel[(size_t)(b * MOBA_H + h) * SEQ + qi * 256 + F.wave * 32 + kg * 16 + qn] = kg ? mask[1] : mask[0];
    }
}
__device__ __forceinline__ void moba_partial_phase(Frame& F, const bf16* MQ, const bf16* MK, const bf16* MV, const unsigned* sel, const moba::PartBufs& PB, gu32* ctr) {
    LAS unsigned* box = (LAS unsigned*)(F.lds + moba::P_BOX);
    for (;;) {
        if (F.tid == 0) box[0] = __hip_atomic_fetch_add(ctr, 1u, __ATOMIC_RELAXED, __HIP_MEMORY_SCOPE_AGENT);
        __syncthreads();
        const int k = (int)box[0];
        if (k >= 31 * 32) break;
        moba::partial_unit(MQ, MK, MV, sel, PB, (k & 31) >> 3, k & 7, k >> 5, F.lds);
    }
}
__device__ __forceinline__ void moba_own_phase(Frame& F, const bf16* MQ, const bf16* MK, const bf16* MV, bf16* OB, const unsigned* sel, const moba::PartBufs& PB) {
    for (int u = F.vcu; u < BATCH * MOBA_H * MOBA_NB; u += F.G) {
        const int qi = u & 31, h = (u >> 5) & 7, b = u >> 8;
        const float sl2 = __builtin_amdgcn_exp2f(-(float)(h + 1)) * moba::LOG2E;
        const size_t qrow = (size_t)b * SEQ + (size_t)qi * 256;
        moba::unit(MQ + qrow * 1024 + h * 128, MK + (size_t)b * SEQ * 1024 + h * 128, MV + (size_t)b * SEQ * 1024 + h * 128, OB,
                   sel + (size_t)(b * MOBA_H + h) * SEQ + qi * 256, PB, (size_t)(b * MOBA_H + h) * SEQ + qi * 256, qi, sl2, F.lds + RING_OFF, (int)qrow, h * 128);
    }
}

struct Args { const float* in[18]; float* out; unsigned char* ws; int ph_lo, ph_hi, li, pad; };
enum { I_X = 0, I_N1, I_WG1, I_WU1, I_WD1, I_NMIX, I_WIN, I_WALPHA, I_BALPHA, I_GONORM, I_WBG, I_WBM, I_WOUT, I_N2, I_WG2, I_WU2, I_WD2, I_NF };

__global__ void __launch_bounds__(NWAVES * 64, 2) mk_fwd(Args args) {
    extern __shared__ __attribute__((aligned(16))) unsigned char lds[];
    Frame F;
    F.lds = (LAS unsigned char*)lds;
    F.MISC = (volatile LAS unsigned*)(F.lds + MISC_OFF);
    F.tid = threadIdx.x; F.lane = F.tid & 63; F.wave = __builtin_amdgcn_readfirstlane(F.tid >> 6);
    F.G = gridDim.x; { const int bx = blockIdx.x; F.vcu = (F.G % 8 == 0) ? (bx % 8) * (F.G / 8) + bx / 8 : bx; }
    unsigned char* ws = args.ws;
    F.ctl = (gu32*)(ws + WS_CTL);
    for (int u = F.tid; u < (LDS_BYTES - LDSCTL_OFF) / 4; u += NWAVES * 64) ((LAS unsigned*)(F.lds + LDSCTL_OFF))[u] = 0u;
    __syncthreads();
    XcdBarrier bar; bar.bar = (unsigned*)(F.ctl + CW_BAR); bar.x = 0; bar.st = nullptr;
    if (!MK_PER_PHASE) bar = xcd_barrier_post((unsigned*)(F.ctl + CW_BAR), F.MISC + 8);
#define GRID_BAR() do { if (!MK_PER_PHASE) xcd_barrier(bar); } while (0)
    const int lo = args.ph_lo, hi = args.ph_hi;
#define REP(id, ...) do { __VA_ARGS__; if (MK_PROBE_ID == (id)) { __VA_ARGS__; } } while (0)
#define IN(k) (lo <= (k) && (k) < hi)
#define BOTH(k) (IN(k) && IN((k) + 1))
    const float* x = args.in[I_X]; float* out = args.out;
    bf16* WGU = (bf16*)(ws + WS_WGU); bf16* WD = (bf16*)(ws + WS_WD); bf16* WIN = (bf16*)(ws + WS_WIN); bf16* WBG = (bf16*)(ws + WS_WBG); bf16* WBM = (bf16*)(ws + WS_WBM); bf16* WO = (bf16*)(ws + WS_WO); bf16* WD1A = (bf16*)(ws + WS_WD1);
    bf16* XN = (bf16*)(ws + WS_XN); bf16* HID = (bf16*)(ws + WS_R1); unsigned char* R1 = ws + WS_R1;
    bf16* OA = XN; bf16* OB = XN + (size_t)M * 1024; bf16* YM = (bf16*)(R1 + R1_GQ);
    float* SQP = (float*)(ws + WS_PSTAT);
    float* RS0 = (float*)(ws + WS_MISC + 3 * MiB); float* RS1 = RS0 + M; float* RS2 = RS1 + M;
    bf16* X1 = (bf16*)out; bf16* X2 = (bf16*)(R1 + R1_GA); bf16* X3 = XN;

    if (IN(0)) {
        REP(1, { int cur = 0;
        transpose_weight(F, args.in[I_WG1], DM, DFF, WGU, MapGU{0}, cur, 0, args.in[I_N1]);
        transpose_weight(F, args.in[I_WU1], DM, DFF, WGU, MapGU{1}, cur, 0, args.in[I_N1]);
        transpose_weight(F, args.in[I_WD1], DFF, DM, WD, MapId{}, cur);
        transpose_weight(F, args.in[I_WIN], DM, D_IN, WIN, MapIn{}, cur, 0, args.in[I_NMIX]);
        transpose_weight(F, args.in[I_WBG], 1024, DM, WBG, MapId{}, cur);
        transpose_weight(F, args.in[I_WBM], 1024, DM, WBM, MapId{}, cur);
        transpose_weight(F, args.in[I_WOUT], DM, DM, WO, MapId{}, cur);
        zero_rows_tiled(F, WIN, D_IN, NPROJ, DM); });
        REP(2, rs_pass<2>(F, LdRowF32{x, F.lane}, StRowBf16{XN, F.lane}, RS0));
        if (BOTH(0)) GRID_BAR();
    }
    constexpr int MH = M;
#define FFN_GU(half, XNp, LDH, RSp) do { pg8::Gemm g{(XNp) + (size_t)(half) * MH * DM, WGU, MH, 2 * DFF, DM}; pg8::StaticOrder S; S.init(MH, 2 * DFF, F.G, (int)blockIdx.x); \
        pg8::EpiSwiGLU E{HID + (size_t)(half) * MH * (LDH), (LDH), (RSp), nullptr}; pg8::gemm_phase<pg8::EpiSwiGLU, pg8::StaticOrder, true, true>(F.lds + RING_OFF, g, S, E); } while (0)
#define FFN_DOWN(half, RF32, Rp, Op) do { pg8::Gemm g{HID + (size_t)(half) * MH * DFF, WD, MH, DM, DFF}; pg8::StaticOrder S; S.init(MH, DM, F.G, (int)blockIdx.x, 4); \
        pg8::EpiResidBf<RF32> E{(Rp) + (size_t)(half) * MH * DM, (Op) + (size_t)(half) * MH * DM, DM, 0.5f, SQP}; pg8::gemm_phase<pg8::EpiResidBf<RF32>, pg8::StaticOrder, true, true>(F.lds + RING_OFF, g, S, E); } while (0)
    if (IN(1)) { FFN_GU(0, XN, DFF, RS0); if (BOTH(1)) GRID_BAR(); }
    if (IN(2)) { REP(3, FFN_DOWN(0, false, XN, X1)); if (BOTH(2)) GRID_BAR(); }
    if (IN(3)) {
        REP(4, rs_finalize(F, SQP, RS1));
        if (BOTH(3)) GRID_BAR();
    }
    if (IN(4)) {
        pg8::Gemm g{X1, WIN, M, NPROJ, DM}; pg8::StaticOrder S; S.init(M, NPROJ, F.G, (int)blockIdx.x);
        pg8::EpiProj E{R1, RS1, nullptr, (float*)(ws + WS_CTL + 512 * 1024)};
        REP(5, pg8::gemm_phase<pg8::EpiProj, pg8::StaticOrder, true, true>(F.lds + RING_OFF, g, S, E));
        if (BOTH(4)) GRID_BAR();
    }
    const bf16* MQ = (const bf16*)(R1 + R1_MQ); const bf16* MKp = (const bf16*)(R1 + R1_MK); const bf16* MV = (const bf16*)(R1 + R1_MV);
    float* KMEAN = (float*)(ws + WS_CTL + 512 * 1024);      unsigned* SEL = (unsigned*)(ws + WS_MISC + MISC_SEL);
    const gla::Tensors GX{(const bf16*)(R1 + R1_GQ), (const bf16*)(R1 + R1_GK), (const bf16*)(R1 + R1_GV), (const bf16*)(R1 + R1_GR), (const float*)(R1 + R1_GLR),
                          args.in[I_WALPHA], args.in[I_BALPHA], args.in[I_GONORM], (bf16*)(ws + WS_GLAS), (float*)(ws + WS_MISC + MISC_DEC), OA, (bf16*)(ws + WS_WGU), (bf16*)(ws + WS_WGU + 32 * MiB)};
    const moba::PartBufs PB{(bf16*)(R1 + R1_GQ), (float*)(ws + WS_PSTAT), (float*)(ws + WS_PSTAT + 3 * MiB)};
    if (IN(5)) { REP(6, gla_pass<false>(F, GX)); REP(8, moba_select_phase(F, MQ, KMEAN, SEL)); if (BOTH(5)) GRID_BAR(); }
    if (IN(6)) { gla_scan(F, GX); if (BOTH(6)) GRID_BAR(); }
    if (IN(7)) { REP(9, gla_pass<true>(F, GX)); if (BOTH(7)) GRID_BAR(); }
    if (IN(8)) { moba_partial_phase(F, MQ, MKp, MV, SEL, PB, F.ctl + CW_QUEUE); if (MK_PROBE_ID == 10) moba_partial_phase(F, MQ, MKp, MV, SEL, PB, F.ctl + CW_QUEUE + 64); if (BOTH(8)) GRID_BAR(); }
    if (IN(9)) { REP(11, moba_own_phase(F, MQ, MKp, MV, OB, SEL, PB)); if (BOTH(9)) GRID_BAR(); }
    if (IN(10)) {
        REP(12, {
        { pg8::Gemm g{OA, WBG, M, DM, 1024}; pg8::StaticOrder S; S.init(M, DM, F.G, (int)blockIdx.x, 4);
          pg8::EpiGateMul<false> E{(bf16*)(R1 + R1_GA), (bf16*)(R1 + R1_GA), YM, DM};
          pg8::gemm_phase<pg8::EpiGateMul<false>, pg8::StaticOrder, true, true>(F.lds + RING_OFF, g, S, E); }
        { pg8::Gemm g{OB, WBM, M, DM, 1024}; pg8::StaticOrder S; S.init(M, DM, F.G, (int)blockIdx.x, 4);
          pg8::EpiGateMul<true> E{(bf16*)(R1 + R1_GB), (bf16*)(R1 + R1_GA), YM, DM};
          pg8::gemm_phase<pg8::EpiGateMul<true>, pg8::StaticOrder, true, true>(F.lds + RING_OFF, g, S, E); } });
        if (BOTH(10)) GRID_BAR();
    }
    if (IN(11)) {
        pg8::Gemm g{YM, WO, M, DM, DM}; pg8::StaticOrder S; S.init(M, DM, F.G, (int)blockIdx.x, 4);
        pg8::EpiResidBf<false> E{X1, X2, DM, 1.0f, SQP};
        REP(13, pg8::gemm_phase<pg8::EpiResidBf<false>, pg8::StaticOrder, true, true>(F.lds + RING_OFF, g, S, E));
        if (MK_PROBE_ID == 18) { pg8::EpiStoreBf E2{(bf16*)(R1 + R1_GA), DM, 1.0f}; pg8::gemm_phase<pg8::EpiStoreBf, pg8::StaticOrder, true, true>(F.lds + RING_OFF, g, S, E2); }
        if (BOTH(11)) GRID_BAR();
    }
    if (IN(12)) {
        REP(14, { int cur = 0;
        transpose_weight(F, args.in[I_WG2], DM, DFF, WGU, MapGU{0}, cur, 0, args.in[I_N2]);
        transpose_weight(F, args.in[I_WU2], DM, DFF, WGU, MapGU{1}, cur, 0, args.in[I_N2]);
        transpose_weight(F, args.in[I_WD2], DFF, DM, WD, MapId{}, cur); });
        REP(15, rs_finalize(F, SQP, RS2));
        if (BOTH(12)) GRID_BAR(); }
    if (IN(13)) { FFN_GU(0, X2, DFF, RS2); if (BOTH(13)) GRID_BAR(); }
#define FFN_DOWN_NR(half, Op) do { pg8::Gemm g{HID + (size_t)(half) * MH * DFF, WD, MH, DM, DFF}; pg8::StaticOrder S; S.init(MH, DM, F.G, (int)blockIdx.x, 4); \
        pg8::EpiStoreBf E{(Op) + (size_t)(half) * MH * DM, DM, 0.5f}; pg8::gemm_phase<pg8::EpiStoreBf, pg8::StaticOrder, true, true>(F.lds + RING_OFF, g, S, E); } while (0)
    if (IN(14)) { FFN_DOWN_NR(0, X3); if (BOTH(14)) GRID_BAR(); }
#undef FFN_DOWN_NR
#undef FFN_GU
#undef FFN_DOWN
    if (IN(15)) { REP(16, rms_pass<2>(F, args.in[I_NF], LdRowBf16SumT{X2, X3, F.lane}, StRowF32{out, F.lane})); }
#undef IN
#undef BOTH
}

extern "C" void kernel_launch(void* const* d_in, const int* in_sizes, int n_in, void* d_out, int out_size, void* d_ws, size_t ws_size, hipStream_t stream) {
    static int grid = 0;
    if (grid == 0) {
        if (n_in != 18 || in_sizes[0] != M * DM || out_size != M * DM || ws_size < WS_END) { fprintf(stderr, "kernel_launch: unexpected shapes (n_in %d, in0 %d, out %d, ws %zu < %zu)\n", n_in, n_in > 0 ? in_sizes[0] : -1, out_size, ws_size, (size_t)WS_END); grid = -1; return; }
        int dev = 0, cus = 0, per_cu = 0;
        if (hipGetDevice(&dev) != hipSuccess || hipDeviceGetAttribute(&cus, hipDeviceAttributeMultiprocessorCount, dev) != hipSuccess) { grid = -1; return; }
        if (hipFuncSetAttribute((const void*)mk_fwd, hipFuncAttributeMaxDynamicSharedMemorySize, LDS_BYTES) != hipSuccess) { fprintf(stderr, "kernel_launch: hipFuncSetAttribute failed\n"); grid = -1; return; }
        if (hipOccupancyMaxActiveBlocksPerMultiprocessor(&per_cu, (const void*)mk_fwd, NWAVES * 64, LDS_BYTES) != hipSuccess || per_cu < 1) { fprintf(stderr, "kernel_launch: occupancy query says %d\n", per_cu); }
        (void)hipGetLastError();
        grid = cus;
    }
    if (grid < 0) return;
    if (hipMemsetAsync((char*)d_ws + WS_CTL, 0, CTL_ZERO_BYTES, stream) != hipSuccess) return;
    Args a{};
    for (int i = 0; i < 18; ++i) a.in[i] = (const float*)d_in[i];
    a.out = (float*)d_out; a.ws = (unsigned char*)d_ws; a.pad = 0;
#if MK_PER_PHASE
    for (int p = 0; p < N_PHASES; ++p) { a.ph_lo = p; a.ph_hi = p + 1; a.li = p; hipLaunchKernelGGL(mk_fwd, dim3(grid), dim3(NWAVES * 64), LDS_BYTES, stream, a); }
#else
    a.ph_lo = 0; a.ph_hi = N_PHASES; a.li = 0;
    hipLaunchKernelGGL(mk_fwd, dim3(grid), dim3(NWAVES * 64), LDS_BYTES, stream, a);
#endif
    const hipError_t le = hipPeekAtLastError();
    if (le != hipSuccess) fprintf(stderr, "kernel_launch: launch failed: %s\n", hipGetErrorName(le));
}
```

```cpp
#include <hip/hip_runtime.h>
#include <cstdio>
#include <cstdint>
namespace pg8 {
#define PG8_LAS __attribute__((address_space(3)))
typedef unsigned short bf16_t;
typedef short bf16x8 __attribute__((ext_vector_type(8)));
typedef float f32x4 __attribute__((ext_vector_type(4)));
typedef unsigned u32x4 __attribute__((ext_vector_type(4)));
constexpr int BM = 256, BK = 64, HALF = 128, HTB = HALF * BK * 2  , STAGE_BYTES = 8 * HTB, NXCD = 8, WGM = 8;

__host__ __device__ __forceinline__ int lds_byte(int r, int c) { const int st = (r >> 4) * 2 + (c >> 5), rr = r & 15, cc = c & 31, ob = rr * 64 + cc * 2; return st * 1024 + (ob ^ (((ob >> 9) & 1) << 5)); }
__host__ __device__ __forceinline__ void stage_rc(int b, int& R, int& C) { const int st = b / 1024, sb = b % 1024, swz = sb ^ (((sb >> 9) & 1) << 5); R = (st >> 1) * 16 + swz / 64; C = (st & 1) * 32 + (swz % 64) / 2; }
__host__ __device__ __forceinline__ int perm32(int rho) { const int n = rho >> 4, i = rho & 15; return 8 * (i >> 2) + 4 * n + (i & 3); }

__host__ __device__ __forceinline__ size_t tiled_off(int row, int col, int K) { return ((size_t)((row >> 8) * (K >> 6) + (col >> 6)) * 2 + ((row >> 7) & 1)) * 16384 + (size_t)lds_byte(row & 127, col & 63); }
__host__ __device__ __forceinline__ int inv_perm32(int c) { return ((c >> 2) & 1) * 16 + (((c >> 3) << 2) | (c & 3)); }
struct Unit { int pm, pn; };
struct Gemm { const bf16_t* A; const bf16_t* Bt; int M, N, K; int nt, ntm, jt; };

struct StaticOrder {
    int nM, nN, nwg, G, c, wgm;
    __host__ __device__ void init(int M, int N, int G_, int c_, int wgm_ = WGM) { nM = M / BM; nN = N / BM; nwg = nM * nN; G = G_; c = c_; wgm = wgm_; }
    __host__ __device__ bool next(int i, Unit& u) const {
        const long L = (long)i * G + c; if (L >= nwg) return false;
        int wgid = (int)L; { const int q = nwg / NXCD, r = nwg % NXCD, xcd = wgid % NXCD, off = wgid / NXCD; wgid = (xcd < r ? xcd * (q + 1) : r * (q + 1) + (xcd - r) * q) + off; }
        const int nig = wgm * nN, gid = wgid / nig, fm = gid * wgm, gsz = (nM - fm) < wgm ? (nM - fm) : wgm;
        u.pm = fm + ((wgid % nig) % gsz); u.pn = (wgid % nig) / gsz; return true;
    }
    __device__ __forceinline__ void a_ready(const Unit&) const {}
    __device__ __forceinline__ void done(const Unit&) const {}
};

typedef float f32x2_t __attribute__((ext_vector_type(2))); typedef __bf16 bf16x2_t __attribute__((ext_vector_type(2)));
__device__ __forceinline__ unsigned cvt_pk_bf16(float lo, float hi) { f32x2_t v = {lo, hi}; bf16x2_t b = __builtin_convertvector(v, bf16x2_t); return __builtin_bit_cast(unsigned, b); }
__device__ __forceinline__ float fast_sigmoid(float x) { return __builtin_amdgcn_rcpf(1.0f + __builtin_amdgcn_exp2f(-1.4426950408889634f * x)); }
__device__ __forceinline__ float fast_silu(float x) { return x * fast_sigmoid(x); }
__device__ __forceinline__ float bf_lo(unsigned w) { return __builtin_bit_cast(float, w << 16); }
__device__ __forceinline__ float bf_hi(unsigned w) { return __builtin_bit_cast(float, w & 0xffff0000u); }

struct EpiSwiGLU {
    static constexpr bool PERM = true, AFTER_DRAIN = false;
    __device__ __forceinline__ void prefetch(const Unit&, int, int, int, int, PG8_LAS unsigned char*) const {}
    bf16_t* H; int ldh; const float* rs;
    __device__ __forceinline__ void operator()(const f32x4 (&acc)[2][2][4][2], const Unit& u, int wr, int wc, int fr, int fq) const {
        const int row0 = u.pm * BM + wr * 64 + fr, col0 = u.pn * HALF + wc * 32 + 8 * fq;
        float rr[2][4];
#pragma unroll
        for (int ai = 0; ai < 2; ++ai)
#pragma unroll
            for (int m = 0; m < 4; ++m) rr[ai][m] = rs[row0 + ai * HALF + m * 16];
#pragma unroll
        for (int ai = 0; ai < 2; ++ai)
#pragma unroll
            for (int m = 0; m < 4; ++m) { bf16_t* rowp = (bf16_t*)((unsigned char*)H + tiled_off(row0 + ai * HALF + m * 16, col0, ldh));
                const float r_ = rr[ai][m];
                const f32x4 g0 = acc[ai][0][m][0] * r_, g1 = acc[ai][0][m][1] * r_, u0 = acc[ai][1][m][0] * r_, u1 = acc[ai][1][m][1] * r_;
                u32x4 w; w.x = cvt_pk_bf16(fast_silu(g0[0]) * u0[0], fast_silu(g0[1]) * u0[1]); w.y = cvt_pk_bf16(fast_silu(g0[2]) * u0[2], fast_silu(g0[3]) * u0[3]);
                w.z = cvt_pk_bf16(fast_silu(g1[0]) * u1[0], fast_silu(g1[1]) * u1[1]); w.w = cvt_pk_bf16(fast_silu(g1[2]) * u1[2], fast_silu(g1[3]) * u1[3]);
                __builtin_nontemporal_store(w, (u32x4*)rowp); }
    }
};
struct EpiResid {
    static constexpr bool PERM = false, AFTER_DRAIN = false;
    __device__ __forceinline__ void prefetch(const Unit&, int, int, int, int, PG8_LAS unsigned char*) const {}
    const float* R; float* O; int ld; float alpha;
    __device__ __forceinline__ void operator()(const f32x4 (&acc)[2][2][4][2], const Unit& u, int wr, int wc, int fr, int fq) const {
        const int row0 = u.pm * BM + wr * 64 + fr, col0 = u.pn * BM + wc * 32 + 4 * fq;
#pragma unroll
        for (int ai = 0; ai < 2; ++ai)
#pragma unroll
            for (int m = 0; m < 4; ++m) { const size_t off = (size_t)(row0 + ai * HALF + m * 16) * ld + col0;
#pragma unroll
                for (int bj = 0; bj < 2; ++bj)
#pragma unroll
                    for (int n = 0; n < 2; ++n) { const f32x4 r = *(const f32x4*)(R + off + bj * HALF + n * 16); *(f32x4*)(O + off + bj * HALF + n * 16) = r + acc[ai][bj][m][n] * alpha; } }
    }
};
template <bool RF32> struct EpiResidBf {
    static constexpr bool PERM = true, AFTER_DRAIN = false;
    const void* R; bf16_t* O; int ld; float alpha; float* part;
    __device__ __forceinline__ void prefetch(const Unit& u, int wr, int wc, int fr, int fq, PG8_LAS unsigned char* scratch) const {
        const char* p = (const char*)R + ((size_t)(u.pm * BM + wr * 64 + fr) * ld + u.pn * BM + wc * 32 + 8 * fq) * (RF32 ? 4 : 2);
        const size_t rstep = (size_t)16 * ld * (RF32 ? 4 : 2);
#pragma unroll
        for (int i = 0; i < 8; ++i) {
#pragma unroll
            for (int bj = 0; bj < 2; ++bj) {
                __builtin_amdgcn_global_load_lds((const unsigned*)(p + bj * HALF * (RF32 ? 4 : 2)), (PG8_LAS unsigned*)scratch, 16, 0, 0);
                if (RF32) __builtin_amdgcn_global_load_lds((const unsigned*)(p + bj * HALF * 4 + 16), (PG8_LAS unsigned*)scratch, 16, 0, 0); }
            p += (i == 3) ? 5 * rstep : rstep; asm volatile("" : "+v"(p)); }
    }
    __device__ __forceinline__ void operator()(const f32x4 (&acc)[2][2][4][2], const Unit& u, int wr, int wc, int fr, int fq) const {
        const int row0 = u.pm * BM + wr * 64 + fr, col0 = u.pn * BM + wc * 32 + 8 * fq;
        float sq[2][4] = {{0.f, 0.f, 0.f, 0.f}, {0.f, 0.f, 0.f, 0.f}};
        if constexpr (!RF32) {
            u32x4 rw[2][4][2];
#pragma unroll
            for (int ai = 0; ai < 2; ++ai)
#pragma unroll
                for (int m = 0; m < 4; ++m)
#pragma unroll
                    for (int bj = 0; bj < 2; ++bj) rw[ai][m][bj] = *(const u32x4*)((const unsigned char*)R + tiled_off(row0 + ai * HALF + m * 16, col0 + bj * HALF, ld));
#pragma unroll
            for (int ai = 0; ai < 2; ++ai)
#pragma unroll
                for (int m = 0; m < 4; ++m)
#pragma unroll
                    for (int bj = 0; bj < 2; ++bj) { const u32x4 w_ = rw[ai][m][bj];
                        const f32x4 r0 = (f32x4){bf_lo(w_.x), bf_hi(w_.x), bf_lo(w_.y), bf_hi(w_.y)}, r1 = (f32x4){bf_lo(w_.z), bf_hi(w_.z), bf_lo(w_.w), bf_hi(w_.w)};
                        const f32x4 o0 = r0 + acc[ai][bj][m][0] * alpha, o1 = r1 + acc[ai][bj][m][1] * alpha;
                        sq[ai][m] += (o0[0] * o0[0] + o0[1] * o0[1]) + (o0[2] * o0[2] + o0[3] * o0[3]) + (o1[0] * o1[0] + o1[1] * o1[1]) + (o1[2] * o1[2] + o1[3] * o1[3]);
                        u32x4 w; w.x = cvt_pk_bf16(o0[0], o0[1]); w.y = cvt_pk_bf16(o0[2], o0[3]); w.z = cvt_pk_bf16(o1[0], o1[1]); w.w = cvt_pk_bf16(o1[2], o1[3]);
                        *(u32x4*)((unsigned char*)O + tiled_off(row0 + ai * HALF + m * 16, col0 + bj * HALF, ld)) = w; }
        } else {
#pragma unroll
        for (int ai = 0; ai < 2; ++ai) {
            f32x4 r0[4][2], r1[4][2];
#pragma unroll
            for (int m = 0; m < 4; ++m)
#pragma unroll
                for (int bj = 0; bj < 2; ++bj) { const size_t off = (size_t)(row0 + ai * HALF + m * 16) * ld + col0 + bj * HALF;
                    r0[m][bj] = *(const f32x4*)((const float*)R + off); r1[m][bj] = *(const f32x4*)((const float*)R + off + 4); }
#pragma unroll
            for (int m = 0; m < 4; ++m)
#pragma unroll
                for (int bj = 0; bj < 2; ++bj) {
                    const f32x4 o0 = r0[m][bj] + acc[ai][bj][m][0] * alpha, o1 = r1[m][bj] + acc[ai][bj][m][1] * alpha;
                    sq[ai][m] += (o0[0] * o0[0] + o0[1] * o0[1]) + (o0[2] * o0[2] + o0[3] * o0[3]) + (o1[0] * o1[0] + o1[1] * o1[1]) + (o1[2] * o1[2] + o1[3] * o1[3]);
                    u32x4 w; w.x = cvt_pk_bf16(o0[0], o0[1]); w.y = cvt_pk_bf16(o0[2], o0[3]); w.z = cvt_pk_bf16(o1[0], o1[1]); w.w = cvt_pk_bf16(o1[2], o1[3]);
                    *(u32x4*)((unsigned char*)O + tiled_off(row0 + ai * HALF + m * 16, col0 + bj * HALF, ld)) = w; }
        }
        }
#pragma unroll
        for (int ai = 0; ai < 2; ++ai)
#pragma unroll
            for (int m = 0; m < 4; ++m) { float s_ = sq[ai][m]; s_ += __shfl_xor(s_, 16); s_ += __shfl_xor(s_, 32);
                if (fq == 0) part[(size_t)(u.pn * 4 + wc) * (size_t)32768 + row0 + ai * HALF + m * 16] = s_; }
    }
};
struct EpiStoreBf {
    static constexpr bool PERM = true, AFTER_DRAIN = false;
    __device__ __forceinline__ void prefetch(const Unit&, int, int, int, int, PG8_LAS unsigned char*) const {}
    bf16_t* O; int ld; float alpha;
    __device__ __forceinline__ void operator()(const f32x4 (&acc)[2][2][4][2], const Unit& u, int wr, int wc, int fr, int fq) const {
        const int row0 = u.pm * BM + wr * 64 + fr, col0 = u.pn * BM + wc * 32 + 8 * fq;
#pragma unroll
        for (int ai = 0; ai < 2; ++ai)
#pragma unroll
            for (int m = 0; m < 4; ++m)
#pragma unroll
                for (int bj = 0; bj < 2; ++bj) { const size_t off = (size_t)(row0 + ai * HALF + m * 16) * ld + col0 + bj * HALF; const f32x4 o0 = acc[ai][bj][m][0] * alpha, o1 = acc[ai][bj][m][1] * alpha;
                    u32x4 w; w.x = cvt_pk_bf16(o0[0], o0[1]); w.y = cvt_pk_bf16(o0[2], o0[3]); w.z = cvt_pk_bf16(o1[0], o1[1]); w.w = cvt_pk_bf16(o1[2], o1[3]);
                    *(u32x4*)(O + off) = w; }
    }
};
struct EpiProj {
    static constexpr bool PERM = true, AFTER_DRAIN = false;
    __device__ __forceinline__ void prefetch(const Unit&, int, int, int, int, PG8_LAS unsigned char*) const {}
    unsigned char* base;
    const float* rs;
    float* kmean;
    __device__ __forceinline__ void operator()(const f32x4 (&acc)[2][2][4][2], const Unit& u, int wr, int wc, int fr, int fq) const {
        const int pn = u.pn; const int row0 = u.pm * BM + wr * 64 + fr;
        float rr[2][4];
#pragma unroll
        for (int ai = 0; ai < 2; ++ai)
#pragma unroll
            for (int m = 0; m < 4; ++m) rr[ai][m] = rs[row0 + ai * HALF + m * 16];
        if (pn == 40) {
            if (wc == 0 && fq < 2) { float* G = (float*)(base + (size_t)640 * 1048576);
#pragma unroll
                for (int ai = 0; ai < 2; ++ai)
#pragma unroll
                    for (int m = 0; m < 4; ++m) { float* rowp = G + (size_t)(row0 + ai * HALF + m * 16) * 16 + 8 * fq; *(f32x4*)rowp = acc[ai][0][m][0] * rr[ai][m]; *(f32x4*)(rowp + 4) = acc[ai][0][m][1] * rr[ai][m]; } }
            return;
        }
        size_t boff; int ld, t0, act = 0; bool gran = false;
        if (pn < 2) { boff = 0; ld = 512; t0 = 0; gran = true; } else if (pn < 4) { boff = 32; ld = 512; t0 = 2; gran = true; } else if (pn < 8) { boff = 64; ld = 1024; t0 = 4; }
        else if (pn < 12) { boff = 128; ld = 1024; t0 = 8; act = 1; gran = true; } else if (pn < 16) { boff = 192; ld = 1024; t0 = 12; } else if (pn < 20) { boff = 256; ld = 1024; t0 = 16; }
        else if (pn < 24) { boff = 320; ld = 1024; t0 = 20; } else if (pn < 32) { boff = 384; ld = 2048; t0 = 24; act = 2; } else { boff = 512; ld = 2048; t0 = 32; act = 2; }
        bf16_t* O = (bf16_t*)(base + boff * 1048576); const int col0 = (pn - t0) * BM + wc * 32 + 8 * fq;
        if (pn >= 16 && pn < 20) {
#pragma unroll
            for (int bj = 0; bj < 2; ++bj) { f32x4 s0 = {0.f, 0.f, 0.f, 0.f}, s1 = {0.f, 0.f, 0.f, 0.f};
#pragma unroll
                for (int ai = 0; ai < 2; ++ai)
#pragma unroll
                    for (int m = 0; m < 4; ++m) { s0 = s0 + acc[ai][bj][m][0] * rr[ai][m]; s1 = s1 + acc[ai][bj][m][1] * rr[ai][m]; }
#pragma unroll
                for (int j = 0; j < 4; ++j) {
#pragma unroll
                    for (int o = 1; o < 16; o <<= 1) { s0[j] += __shfl_xor(s0[j], o); s1[j] += __shfl_xor(s1[j], o); } }
                if (fr == 0) { float* kp = kmean + (size_t)u.pm * 1024 + col0 + bj * HALF;
#pragma unroll
                    for (int j = 0; j < 4; ++j) { atomicAdd(kp + j, s0[j] * (1.0f / 256.0f)); atomicAdd(kp + 4 + j, s1[j] * (1.0f / 256.0f)); } } }
        }
#pragma unroll
        for (int ai = 0; ai < 2; ++ai)
#pragma unroll
            for (int m = 0; m < 4; ++m) { bf16_t* rowp = O + (size_t)(row0 + ai * HALF + m * 16) * ld + col0;
#pragma unroll
                for (int bj = 0; bj < 2; ++bj) { f32x4 v0 = acc[ai][bj][m][0] * rr[ai][m], v1 = acc[ai][bj][m][1] * rr[ai][m];
                    if (act == 1) {
#pragma unroll
                        for (int j = 0; j < 4; ++j) { v0[j] = fast_silu(v0[j]); v1[j] = fast_silu(v1[j]); } }
                    else if (act == 2) {
#pragma unroll
                        for (int j = 0; j < 4; ++j) { v0[j] = fast_sigmoid(v0[j]); v1[j] = fast_sigmoid(v1[j]); } }
                    u32x4 w; w.x = cvt_pk_bf16(v0[0], v0[1]); w.y = cvt_pk_bf16(v0[2], v0[3]); w.z = cvt_pk_bf16(v1[0], v1[1]); w.w = cvt_pk_bf16(v1[2], v1[3]);
                    if (act == 2) {
                        const int lane_ = fq * 16 + fr, wv = wr * 4 + wc, grp = (ai * 4 + m) * 2 + bj;
                        *(u32x4*)(O + ((((size_t)(u.pm * 8 + (pn - t0)) * 8 + wv) * 16 + grp) * 64 + lane_) * 8) = w; }
                    else if (gran) { const int row = row0 + ai * HALF + m * 16, c = col0 + bj * HALF; typedef unsigned u32x2_t __attribute__((ext_vector_type(2)));
                        bf16_t* gp = O + ((size_t)((row >> 5) * (ld >> 2) + (c >> 2)) * 32 + (row & 31)) * 4;
                        *(u32x2_t*)gp = (u32x2_t){w.x, w.y}; *(u32x2_t*)(gp + 128) = (u32x2_t){w.z, w.w}; }
                    else __builtin_nontemporal_store(w, (u32x4*)(rowp + bj * HALF)); } }
    }
};
template <bool ACCUM> struct EpiGateMul {
    static constexpr bool PERM = true, AFTER_DRAIN = false;
    __device__ __forceinline__ void prefetch(const Unit&, int, int, int, int, PG8_LAS unsigned char*) const {}
    bf16_t* G; bf16_t* T; bf16_t* Y; int ld;
    __device__ __forceinline__ void operator()(const f32x4 (&acc)[2][2][4][2], const Unit& u, int wr, int wc, int fr, int fq) const {
        const int row0 = u.pm * BM + wr * 64 + fr, col0 = u.pn * BM + wc * 32 + 8 * fq;
        const size_t lp0 = (((size_t)(u.pm * 8 + u.pn) * 8 + (wr * 4 + wc)) * 16) * 64 + (fq * 16 + fr);
#pragma unroll
        for (int ai = 0; ai < 2; ++ai) {
            u32x4 gw[4][2], tw[4][2];
#pragma unroll
            for (int m = 0; m < 4; ++m)
#pragma unroll
                for (int bj = 0; bj < 2; ++bj) { const size_t lp = (lp0 + (size_t)((ai * 4 + m) * 2 + bj) * 64) * 8;
                    gw[m][bj] = *(const u32x4*)(G + lp); if (ACCUM) tw[m][bj] = *(const u32x4*)(T + lp); }
#pragma unroll
            for (int m = 0; m < 4; ++m)
#pragma unroll
                for (int bj = 0; bj < 2; ++bj) { const size_t lp = (lp0 + (size_t)((ai * 4 + m) * 2 + bj) * 64) * 8;
                    const f32x4 a0 = acc[ai][bj][m][0], a1 = acc[ai][bj][m][1]; const u32x4 g = gw[m][bj];
                    float v[8] = {bf_lo(g.x) * a0[0], bf_hi(g.x) * a0[1], bf_lo(g.y) * a0[2], bf_hi(g.y) * a0[3], bf_lo(g.z) * a1[0], bf_hi(g.z) * a1[1], bf_lo(g.w) * a1[2], bf_hi(g.w) * a1[3]};
                    if (ACCUM) { const u32x4 y = tw[m][bj];
                        v[0] += bf_lo(y.x); v[1] += bf_hi(y.x); v[2] += bf_lo(y.y); v[3] += bf_hi(y.y); v[4] += bf_lo(y.z); v[5] += bf_hi(y.z); v[6] += bf_lo(y.w); v[7] += bf_hi(y.w); }
                    u32x4 w; w.x = cvt_pk_bf16(v[0], v[1]); w.y = cvt_pk_bf16(v[2], v[3]); w.z = cvt_pk_bf16(v[4], v[5]); w.w = cvt_pk_bf16(v[6], v[7]);
                    if (ACCUM) *(u32x4*)((unsigned char*)Y + tiled_off(row0 + ai * HALF + m * 16, col0 + bj * HALF, ld)) = w; else *(u32x4*)(G + lp) = w; }
        }
    }
};

template <class Epi, class Sched, bool ALIGN_EPI = false, bool SP2 = false>
__device__ __forceinline__ void gemm_phase(PG8_LAS unsigned char* lds, const Gemm g, const Sched& S, const Epi& E) {
    int tid_ = threadIdx.x; asm volatile("" : "+v"(tid_));
    const int tid = tid_, wid = __builtin_amdgcn_readfirstlane(tid >> 6), lane = tid & 63, wr = wid >> 2, wc = wid & 3, fr = lane & 15, fq = lane >> 4;
    const int K = g.K, nt = g.nt ? g.nt : K / BK, ntm = g.nt ? g.ntm : nt, jt = g.nt ? g.jt : 0;
    unsigned voffA[2], voffB[2];
#pragma unroll
    for (int i = 0; i < 2; ++i) { voffA[i] = (unsigned)(tid * 16 + i * 8192); voffB[i] = voffA[i]; }
    const size_t kstep = 32768;
    const size_t hstep = 16384;
    const size_t tstep = (size_t)(K / BK) * kstep;
    const unsigned ldsw = (unsigned)wid * 1024u;
    const int aoff = lds_byte(wr * 64 + fr, fq * 8), boff = lds_byte(wc * 32 + fr, fq * 8);
#define PG8_SA(b, h) (((b) * 2 + (h)) * HTB)
#define PG8_SB(b, h) ((4 + (b) * 2 + (h)) * HTB)
#define PG8_STAGE(bufoff, gbase, voff) do { _Pragma("unroll") for (int _i = 0; _i < 2; ++_i) \
        __builtin_amdgcn_global_load_lds((const unsigned*)((const char*)(gbase) + (voff)[_i]), (PG8_LAS unsigned*)(lds + (bufoff) + ldsw + _i * 8192), 16, 0, 0); } while (0)
#define PG8_LDA(dst, b, h) do { _Pragma("unroll") for (int m = 0; m < 4; ++m) _Pragma("unroll") for (int k = 0; k < 2; ++k) dst[m][k] = *(const PG8_LAS bf16x8*)(lds + PG8_SA(b, h) + aoff + m * 2048 + k * 1024); } while (0)
#define PG8_LDB(dst, b, h) do { _Pragma("unroll") for (int n = 0; n < 2; ++n) _Pragma("unroll") for (int k = 0; k < 2; ++k) dst[n][k] = *(const PG8_LAS bf16x8*)(lds + PG8_SB(b, h) + boff + n * 2048 + k * 1024); } while (0)
#define PG8_MMA(ai, bj, At, Bt) do { __builtin_amdgcn_s_setprio(1); _Pragma("unroll") for (int m = 0; m < 4; ++m) _Pragma("unroll") for (int n = 0; n < 2; ++n) _Pragma("unroll") for (int k = 0; k < 2; ++k) \
        acc[ai][bj][m][n] = __builtin_amdgcn_mfma_f32_16x16x32_bf16(Bt[n][k], At[m][k], acc[ai][bj][m][n], 0, 0, 0); __builtin_amdgcn_s_setprio(0); } while (0)
#define PG8_WAIT_V(n) asm volatile("s_waitcnt vmcnt(" #n ")" ::: "memory")
#define PG8_WAIT_L(n) asm volatile("s_waitcnt lgkmcnt(" #n ")" ::: "memory")
#define PG8_BAR __builtin_amdgcn_s_barrier()
#define PG8_SCHED __builtin_amdgcn_sched_barrier(0)
    Unit cur, nxt; int ui = 0;
    if (!S.next(0, cur)) return;
    f32x4 acc[2][2][4][2];
#pragma unroll
    for (int a = 0; a < 2; ++a)
#pragma unroll
        for (int b = 0; b < 2; ++b)
#pragma unroll
            for (int m = 0; m < 4; ++m)
#pragma unroll
                for (int n = 0; n < 2; ++n) acc[a][b][m][n] = (f32x4){0.f, 0.f, 0.f, 0.f};
    bf16x8 At[4][2], B0[2][2], B1[2][2];
    const char* cA = (const char*)g.A + (size_t)cur.pm * tstep; const char* cB = (const char*)g.Bt + (size_t)cur.pn * tstep;
    S.a_ready(cur);
    if constexpr (SP2) {
        PG8_STAGE(PG8_SB(0, 0), cB, voffB); PG8_STAGE(PG8_SB(0, 1), cB + hstep, voffB); PG8_STAGE(PG8_SA(0, 0), cA, voffA); PG8_STAGE(PG8_SA(0, 1), cA + hstep, voffA);
        if (wr == 1) PG8_BAR;
        PG8_WAIT_V(2); PG8_BAR;
        PG8_STAGE(PG8_SB(1, 0), cB + kstep, voffB); PG8_STAGE(PG8_SA(1, 0), cA + kstep, voffA); PG8_STAGE(PG8_SB(1, 1), cB + hstep + kstep, voffB);
        PG8_WAIT_V(6); PG8_BAR;
    } else {
        PG8_STAGE(PG8_SB(0, 0), cB, voffB); PG8_STAGE(PG8_SA(0, 0), cA, voffA); PG8_STAGE(PG8_SB(0, 1), cB + hstep, voffB); PG8_STAGE(PG8_SA(0, 1), cA + hstep, voffA);
        if (wr == 1) PG8_BAR;
        PG8_WAIT_V(4); PG8_BAR;
        PG8_STAGE(PG8_SB(1, 0), cB + kstep, voffB); PG8_STAGE(PG8_SA(1, 0), cA + kstep, voffA); PG8_STAGE(PG8_SB(1, 1), cB + hstep + kstep, voffB);
        PG8_WAIT_V(6); PG8_BAR;
    }
    for (;;) {
        const bool has_next = S.next(ui + 1, nxt);
        const char* nA = has_next ? (const char*)g.A + (size_t)nxt.pm * tstep : cA; const char* nB = has_next ? (const char*)g.Bt + (size_t)nxt.pn * tstep : cB;
        for (int t = 0; t < nt; t += 2) {
            const bool last = (t == nt - 2);
#define PG8_KO(tt) ((size_t)(tt) * kstep + ((tt) >= ntm ? jmp : (size_t)0))
            const size_t jmp = (size_t)(cur.pn * jt) * kstep;
            const char* a1 = cA + PG8_KO(t + 1);
            const char* a2 = last ? nA : cA + PG8_KO(t + 2); const char* b2 = last ? nB : cB + PG8_KO(t + 2);
            const char* a3 = last ? nA + kstep : cA + PG8_KO(t + 3); const char* b3 = last ? nB + kstep : cB + PG8_KO(t + 3);
#undef PG8_KO
            if (last && has_next) S.a_ready(nxt);
            if constexpr (SP2) {
            PG8_LDB(B0, 0, 0); PG8_LDB(B1, 0, 1); PG8_SCHED; PG8_LDA(At, 0, 0); PG8_STAGE(PG8_SA(1, 1), a1 + hstep, voffA);
            PG8_WAIT_V(8); PG8_WAIT_L(0); PG8_BAR; PG8_MMA(0, 0, At, B0); PG8_MMA(0, 1, At, B1); PG8_BAR; PG8_SCHED;
            PG8_LDA(At, 0, 1); PG8_STAGE(PG8_SB(0, 0), b2, voffB); PG8_STAGE(PG8_SB(0, 1), b2 + hstep, voffB); PG8_STAGE(PG8_SA(0, 0), a2, voffA);
            PG8_WAIT_V(8); PG8_WAIT_L(0); PG8_BAR; PG8_MMA(1, 0, At, B0); PG8_MMA(1, 1, At, B1); PG8_BAR; PG8_SCHED;
            PG8_LDB(B0, 1, 0); PG8_LDB(B1, 1, 1); PG8_SCHED; PG8_LDA(At, 1, 0); PG8_STAGE(PG8_SA(0, 1), a2 + hstep, voffA);
            PG8_WAIT_V(8); PG8_WAIT_L(0); PG8_BAR; PG8_MMA(0, 0, At, B0); PG8_MMA(0, 1, At, B1); PG8_BAR; PG8_SCHED;
            PG8_LDA(At, 1, 1); PG8_STAGE(PG8_SB(1, 0), b3, voffB); PG8_STAGE(PG8_SB(1, 1), b3 + hstep, voffB); PG8_STAGE(PG8_SA(1, 0), a3, voffA);
            PG8_WAIT_V(8); PG8_WAIT_L(0); PG8_BAR; PG8_MMA(1, 0, At, B0); PG8_MMA(1, 1, At, B1); PG8_BAR; PG8_SCHED;
            } else {
            PG8_LDB(B0, 0, 0); PG8_SCHED; PG8_LDA(At, 0, 0); PG8_STAGE(PG8_SA(1, 1), a1 + hstep, voffA);
            PG8_WAIT_L(8); PG8_BAR; PG8_WAIT_L(0); PG8_MMA(0, 0, At, B0); PG8_BAR; PG8_SCHED;
            PG8_LDB(B1, 0, 1); PG8_STAGE(PG8_SB(0, 0), b2, voffB);
            PG8_BAR; PG8_WAIT_L(0); PG8_MMA(0, 1, At, B1); PG8_BAR;
            PG8_LDA(At, 0, 1); PG8_STAGE(PG8_SA(0, 0), a2, voffA);
            PG8_BAR; PG8_WAIT_L(0); PG8_MMA(1, 0, At, B0); PG8_BAR; PG8_SCHED;
            PG8_STAGE(PG8_SB(0, 1), b2 + hstep, voffB);
            PG8_WAIT_V(6); PG8_BAR; PG8_MMA(1, 1, At, B1); PG8_BAR;
            PG8_LDB(B0, 1, 0); PG8_SCHED; PG8_LDA(At, 1, 0); PG8_STAGE(PG8_SA(0, 1), a2 + hstep, voffA);
            PG8_WAIT_L(8); PG8_BAR; PG8_WAIT_L(0); PG8_MMA(0, 0, At, B0); PG8_BAR; PG8_SCHED;
            PG8_LDB(B1, 1, 1); PG8_STAGE(PG8_SB(1, 0), b3, voffB);
            PG8_BAR; PG8_WAIT_L(0); PG8_MMA(0, 1, At, B1); PG8_BAR;
            PG8_LDA(At, 1, 1); PG8_STAGE(PG8_SA(1, 0), a3, voffA);
            PG8_BAR; PG8_WAIT_L(0); PG8_MMA(1, 0, At, B0); PG8_BAR; PG8_SCHED;
            PG8_STAGE(PG8_SB(1, 1), b3 + hstep, voffB);
            PG8_WAIT_V(6); PG8_BAR; PG8_MMA(1, 1, At, B1); PG8_BAR;
            }
        }
        if constexpr (ALIGN_EPI) { if (wr == 0) PG8_BAR; }
        if constexpr (!Epi::AFTER_DRAIN) { E(acc, cur, wr, wc, fr, fq); S.done(cur); }
        if (!has_next) break;
#pragma unroll
        for (int a = 0; a < 2; ++a)
#pragma unroll
            for (int b = 0; b < 2; ++b)
#pragma unroll
                for (int m = 0; m < 4; ++m)
#pragma unroll
                    for (int n = 0; n < 2; ++n) acc[a][b][m][n] = (f32x4){0.f, 0.f, 0.f, 0.f};
        cur = nxt; cA = nA; cB = nB; ++ui;
        if constexpr (ALIGN_EPI) { if (wr == 1) PG8_BAR; }
    }
    PG8_WAIT_V(0);
    if constexpr (!ALIGN_EPI) { if (wr == 0) PG8_BAR; }
    PG8_BAR;
    if constexpr (Epi::AFTER_DRAIN) { E.fused(acc, cur, wr, wc, fr, fq, lds, wid, lane); S.done(cur); }
#undef PG8_SA
#undef PG8_SB
#undef PG8_STAGE
#undef PG8_LDA
#undef PG8_LDB
#undef PG8_MMA
#undef PG8_WAIT_V
#undef PG8_WAIT_L
#undef PG8_BAR
#undef PG8_SCHED
}
}

#define GAS __attribute__((address_space(1)))
#define LAS __attribute__((address_space(3)))
typedef unsigned short bf16;
typedef unsigned v4u __attribute__((ext_vector_type(4)));
typedef float f32x4 __attribute__((ext_vector_type(4)));
typedef short bf16x8 __attribute__((ext_vector_type(8)));
typedef GAS unsigned gu32;
typedef GAS unsigned long long gu64;
#define RLX_AGENT __ATOMIC_RELAXED, __HIP_MEMORY_SCOPE_AGENT
#define LDS_WAIT() asm volatile("s_waitcnt lgkmcnt(0)" ::: "memory")
#define VM_WAIT() asm volatile("s_waitcnt vmcnt(0)" ::: "memory")
__device__ __forceinline__ unsigned long long rt() { return __builtin_amdgcn_s_memrealtime(); }
__device__ __forceinline__ unsigned f2bf(float f) { unsigned u = __builtin_bit_cast(unsigned, f); return (u + 0x7fffu + ((u >> 16) & 1u)) >> 16; }
__device__ __forceinline__ unsigned pk2(float lo, float hi) { return f2bf(lo) | (f2bf(hi) << 16); }

#define XB_TMO      128
#define XB_XCNT(j)  (256  + 64 * (j))
#define XB_XSUB(j)  (1280 + 64 * (j))
#define XB_XGEN(j)  (2304 + 64 * (j))
#define XB_TOP      3328
#define XB_TOPGEN   3392
#define XCD_BAR_WORDS 3456
#define XB_SPIN_CAP (1u << 18)

__device__ __forceinline__ unsigned xb_ld(unsigned* p)              { return __hip_atomic_load(p, __ATOMIC_RELAXED, __HIP_MEMORY_SCOPE_AGENT); }
__device__ __forceinline__ unsigned xb_add(unsigned* p, unsigned v) { return __hip_atomic_fetch_add(p, v, __ATOMIC_RELAXED, __HIP_MEMORY_SCOPE_AGENT); }
__device__ __forceinline__ unsigned xb_xcc_id() { return (unsigned)__builtin_amdgcn_s_getreg((3 << 11) | 20) & 0xFu; }
#define XB_SPIN(cond, bar) do { unsigned _sp = 0; while (cond) { __builtin_amdgcn_s_sleep(1); \
    if ((++_sp & 255u) == 0u) { if (xb_ld(&(bar)[XB_TMO])) break; if (_sp > XB_SPIN_CAP) { atomicAdd(&(bar)[XB_TMO], 1u); break; } } } } while (0)

struct XcdBarrier {
    unsigned* bar; unsigned x;
    volatile LAS unsigned* st;
};

__device__ __forceinline__ XcdBarrier xcd_barrier_post(unsigned* bar, volatile LAS unsigned* st) {
    XcdBarrier b; b.bar = bar; b.x = xb_xcc_id(); b.st = st;
    if (threadIdx.x == 0) (void)xb_add(&bar[XB_XCNT(b.x)], 1u);
    return b;
}
__device__ __forceinline__ void xcd_barrier_complete(unsigned* bar, unsigned x, unsigned& nloc, unsigned& nx) {
    const unsigned G = gridDim.x * gridDim.y * gridDim.z;
    unsigned sum, cnt, mine, sp = 0u;
    for (;;) {
        sum = 0u; cnt = 0u; mine = 0u;
#pragma unroll
        for (unsigned j = 0; j < 16; ++j) { const unsigned c = xb_ld(&bar[XB_XCNT(j)]); sum += c; cnt += (c > 0u) ? 1u : 0u; mine = (j == x) ? c : mine; }
        if (sum == G) break;
        __builtin_amdgcn_s_sleep(1);
        if ((++sp & 255u) == 0u) { if (xb_ld(&bar[XB_TMO])) break; if (sp > XB_SPIN_CAP) { atomicAdd(&bar[XB_TMO], 1u); break; } }
    }
    nloc = mine > 0u ? mine : 1u; nx = cnt > 0u ? cnt : 1u;
}

__device__ __forceinline__ void xcd_barrier(const XcdBarrier& b) {
    asm volatile("s_waitcnt vmcnt(0)" ::: "memory");
    __syncthreads();
    if (threadIdx.x == 0) {
        unsigned* bar = b.bar;
        __builtin_amdgcn_s_waitcnt(0);
        unsigned nloc = b.st[0], nx = b.st[1];
        if (nloc == 0u) { xcd_barrier_complete(bar, b.x, nloc, nx); b.st[0] = nloc; b.st[1] = nx; }
        const unsigned old = xb_add(&bar[XB_XSUB(b.x)], 1u);
        const unsigned gen = old / nloc;
        if (old + 1u == (gen + 1u) * nloc) {
            __builtin_amdgcn_fence(__ATOMIC_RELEASE, "agent");
            asm volatile("s_waitcnt vmcnt(0)" ::: "memory");
            const unsigned og = xb_add(&bar[XB_TOP], 1u);
            const unsigned tg = og / nx;
            if (og + 1u == (tg + 1u) * nx) xb_add(&bar[XB_TOPGEN], 1u);
            else XB_SPIN(xb_ld(&bar[XB_TOPGEN]) == tg, bar);
            __builtin_amdgcn_fence(__ATOMIC_ACQUIRE, "agent");
            xb_add(&bar[XB_XGEN(b.x)], 1u);
            asm volatile("s_waitcnt vmcnt(0)" ::: "memory");
        } else {
            XB_SPIN(xb_ld(&bar[XB_XGEN(b.x)]) == gen, bar);
            __builtin_amdgcn_fence(__ATOMIC_ACQUIRE, "agent");
            asm volatile("s_waitcnt vmcnt(0)" ::: "memory");
        }
    }
    __syncthreads();
}
constexpr int NWAVES = 8;
constexpr int BATCH = 4, SEQ = 8192, DM = 2048, DFF = 5632, M = BATCH * SEQ;
constexpr int GLA_H = 4, GLA_DK = 128, GLA_DV = 256, GLA_RANK = 16;
constexpr int MOBA_H = 8, MOBA_HD = 128, MOBA_BLK = 256, MOBA_NB = SEQ / MOBA_BLK;
constexpr int LDH1 = DFF + DM;
constexpr int D_IN = 10256, NPROJ = 10496;
constexpr float NORM_EPS = 1e-6f;
#ifndef MK_NO_GLA
#define MK_NO_GLA 0
#endif
#ifndef MK_NO_MOBA
#define MK_NO_MOBA 0
#endif
#ifndef MK_PROBE_ID
#define MK_PROBE_ID 0
#endif
#ifndef MK_PER_PHASE
#define MK_PER_PHASE 0
#endif
constexpr int N_PHASES = 16;

constexpr size_t MiB = 1u << 20;
constexpr size_t WS_CTL = 0, CTL_ZERO_BYTES = 1 * MiB;
constexpr size_t WS_WGU = 1 * MiB;
constexpr size_t WS_WD = 45 * MiB;
constexpr size_t WS_WIN = 67 * MiB;
constexpr size_t WS_WBG = 108 * MiB;
constexpr size_t WS_WBM = 112 * MiB;
constexpr size_t WS_WO = 116 * MiB;
constexpr size_t WS_XN = 124 * MiB;
constexpr size_t WS_R1 = 252 * MiB;
constexpr size_t WS_GLAS = 894 * MiB;
constexpr size_t WS_MISC = 958 * MiB;
constexpr size_t WS_PSTAT = 962 * MiB;
constexpr size_t WS_WD1 = 968 * MiB;
constexpr size_t WS_END = 998 * MiB;
constexpr size_t R1_GQ = 0, R1_GK = 32 * MiB, R1_GV = 64 * MiB, R1_GR = 128 * MiB, R1_MQ = 192 * MiB, R1_MK = 256 * MiB, R1_MV = 320 * MiB, R1_GA = 384 * MiB, R1_GB = 512 * MiB, R1_GLR = 640 * MiB;
constexpr size_t MISC_DEC = 0, MISC_KMEAN = 1 * MiB, MISC_SEL = 2 * MiB;
constexpr int CW_TMO = 0, CW_CODE = 1, CW_QUEUE = 64, CW_BAR = 4096;

constexpr int RING_OFF = 0, RING_BYTES = 131072;
constexpr int LDS_BYTES = 163840;
constexpr int LDSCTL_OFF = LDS_BYTES - 512, MISC_OFF = LDSCTL_OFF + 320;

struct Frame {
    LAS unsigned char* lds;
    volatile LAS unsigned* MISC;
    gu32* ctl;
    int tid, lane, wave, vcu, G;
};
__device__ __forceinline__ float wave_sum(float v) {
#pragma unroll
    for (int o = 1; o < 64; o <<= 1) v += __shfl_xor(v, o);
    return v;
}
template <class MAP>
__device__ __forceinline__ void transpose_item(const float* W, int K, int N, bf16* WT, int ldw, const MAP& map, LAS float* scr, int item, int lane, const float* gk) {
    const int nblk = (N + 31) / 32, kb = item / nblk, nb = item % nblk, k0 = 64 * kb, n0 = 32 * nb;
    const int nl = (lane & 31) < (N - n0) ? (lane & 31) : (N - 1 - n0);
    const float* src = W + (size_t)(k0 + (lane >> 5)) * N + n0 + nl;
    float v[32];
#pragma unroll
    for (int i = 0; i < 32; ++i) v[i] = src[(size_t)(2 * i) * N];
#pragma unroll
    for (int i = 0; i < 32; ++i) scr[(2 * i + (lane >> 5)) * 33 + (lane & 31)] = v[i];
    LDS_WAIT(); asm volatile("" ::: "memory");
    const int c = lane & 7;
    f32x4 ga = {1.f, 1.f, 1.f, 1.f}, gb = ga;
    if (gk) { ga = *(const GAS f32x4*)(gk + k0 + 8 * c); gb = *(const GAS f32x4*)(gk + k0 + 8 * c + 4); }
#pragma unroll
    for (int j = 0; j < 4; ++j) { const int n = (lane >> 3) + 8 * j; const LAS float* s = scr + (8 * c) * 33 + n;
        v4u o; o.x = pk2(s[0 * 33] * ga.x, s[1 * 33] * ga.y); o.y = pk2(s[2 * 33] * ga.z, s[3 * 33] * ga.w); o.z = pk2(s[4 * 33] * gb.x, s[5 * 33] * gb.y); o.w = pk2(s[6 * 33] * gb.z, s[7 * 33] * gb.w);
        if (n0 + n < N) { const int mr = map(n0 + n), ir = (mr & ~31) + pg8::inv_perm32(mr & 31);
            *(GAS v4u*)((GAS unsigned char*)WT + pg8::tiled_off(ir, k0 + 8 * c, ldw)) = o; } }
    LDS_WAIT(); asm volatile("" ::: "memory");
}
struct MapId { __device__ __forceinline__ int operator()(int n) const { return n; } };
struct MapGU { int up; __device__ __forceinline__ int operator()(int n) const { return 256 * (n >> 7) + 128 * up + (n & 127); } };
struct MapIn { __device__ __forceinline__ int operator()(int n) const { return n < 3072 ? n : (n < 3088 ? 10240 + (n - 3072) : n - 16); } };
template <class MAP>
__device__ __forceinline__ void transpose_weight(Frame& F, const float* W, int K, int N, bf16* WT, const MAP& map, int& cursor, int ldw = 0, const float* gk = nullptr) {
    LAS float* scr = (LAS float*)(F.lds + RING_OFF + F.wave * 16384);
    const int gw = F.vcu * NWAVES + F.wave, NGW = F.G * NWAVES;
    const int nitems = (K / 64) * ((N + 31) / 32);
    int first = (gw - cursor) % NGW; if (first < 0) first += NGW;
    for (int it = first; it < nitems; it += NGW) transpose_item(W, K, N, WT, ldw ? ldw : K, map, scr, it, F.lane, gk);
    cursor = (cursor + nitems) % NGW;
}
struct NoSide { __device__ __forceinline__ void operator()(int, const f32x4 (&)[8]) const {} };
template <int RPW, class LOADROW, class STOREROW, class SIDE = NoSide>
__device__ __forceinline__ void rms_pass(Frame& F, const float* g, const LOADROW& ld, const STOREROW& st, const SIDE& side = SIDE{}) {
    const int gw = F.vcu * NWAVES + F.wave, NGW = F.G * NWAVES;
    f32x4 gv[8];
#pragma unroll
    for (int j = 0; j < 4; ++j) { gv[2 * j] = *(const GAS f32x4*)(g + 512 * j + 8 * F.lane); gv[2 * j + 1] = *(const GAS f32x4*)(g + 512 * j + 8 * F.lane + 4); }
    for (int m0 = gw * RPW; m0 < M; m0 += NGW * RPW) {
        typename LOADROW::Raw raw[RPW];
#pragma unroll
        for (int r = 0; r < RPW; ++r) ld.load(m0 + r, raw[r]);
#pragma unroll
        for (int r = 0; r < RPW; ++r) { f32x4 v[8]; ld.unpack(raw[r], v); side(m0 + r, v); float s = 0.f;
#pragma unroll
            for (int j = 0; j < 8; ++j) s += (v[j].x * v[j].x + v[j].y * v[j].y) + (v[j].z * v[j].z + v[j].w * v[j].w);
            const float rs = 1.0f / sqrtf(wave_sum(s) * (1.0f / DM) + NORM_EPS);
#pragma unroll
            for (int j = 0; j < 8; ++j) v[j] = v[j] * gv[j] * rs;
            st(m0 + r, v); }
    }
}
struct LdRowF32 { struct Raw { f32x4 q[8]; }; const float* X; int lane;
    __device__ __forceinline__ void load(int m, Raw& w) const { const float* xr = X + (size_t)m * DM + 8 * lane;
#pragma unroll
        for (int j = 0; j < 4; ++j) { w.q[2 * j] = *(const GAS f32x4*)(xr + 512 * j); w.q[2 * j + 1] = *(const GAS f32x4*)(xr + 512 * j + 4); } }
    __device__ __forceinline__ void unpack(const Raw& w, f32x4 (&v)[8]) const {
#pragma unroll
        for (int j = 0; j < 8; ++j) v[j] = w.q[j]; } };
struct LdRowBf16 { struct Raw { v4u q[4]; }; const bf16* X; int lane;
    __device__ __forceinline__ void load(int m, Raw& w) const { const bf16* xr = X + (size_t)m * DM + 8 * lane;
#pragma unroll
        for (int j = 0; j < 4; ++j) w.q[j] = *(const GAS v4u*)(xr + 512 * j); }
    __device__ __forceinline__ void unpack(const Raw& w, f32x4 (&v)[8]) const {
#pragma unroll
        for (int j = 0; j < 4; ++j) { const v4u x = w.q[j]; v[2 * j] = (f32x4){pg8::bf_lo(x.x), pg8::bf_hi(x.x), pg8::bf_lo(x.y), pg8::bf_hi(x.y)}; v[2 * j + 1] = (f32x4){pg8::bf_lo(x.z), pg8::bf_hi(x.z), pg8::bf_lo(x.w), pg8::bf_hi(x.w)}; } } };
struct LdRowBf16Sum { struct Raw { v4u q[4], y[4]; }; const bf16* X; const bf16* Y; int lane;
    __device__ __forceinline__ void load(int m, Raw& w) const { const bf16* xr = X + (size_t)m * DM + 8 * lane; const bf16* yr = Y + (size_t)m * DM + 8 * lane;
#pragma unroll
        for (int j = 0; j < 4; ++j) { w.q[j] = *(const GAS v4u*)(xr + 512 * j); w.y[j] = *(const GAS v4u*)(yr + 512 * j); } }
    __device__ __forceinline__ void unpack(const Raw& w, f32x4 (&v)[8]) const {
#pragma unroll
        for (int j = 0; j < 4; ++j) { const v4u x = w.q[j], y = w.y[j];
            v[2 * j] = (f32x4){pg8::bf_lo(x.x) + pg8::bf_lo(y.x), pg8::bf_hi(x.x) + pg8::bf_hi(y.x), pg8::bf_lo(x.y) + pg8::bf_lo(y.y), pg8::bf_hi(x.y) + pg8::bf_hi(y.y)};
            v[2 * j + 1] = (f32x4){pg8::bf_lo(x.z) + pg8::bf_lo(y.z), pg8::bf_hi(x.z) + pg8::bf_hi(y.z), pg8::bf_lo(x.w) + pg8::bf_lo(y.w), pg8::bf_hi(x.w) + pg8::bf_hi(y.w)}; } } };
struct StRowBf16 { bf16* O; int lane; __device__ __forceinline__ void operator()(int m, const f32x4 (&v)[8]) const {
#pragma unroll
    for (int j = 0; j < 4; ++j) { const f32x4 a = v[2 * j], b = v[2 * j + 1]; v4u o; o.x = pk2(a.x, a.y); o.y = pk2(a.z, a.w); o.z = pk2(b.x, b.y); o.w = pk2(b.z, b.w);
        *(GAS v4u*)((GAS unsigned char*)O + pg8::tiled_off(m, 512 * j + 8 * lane, DM)) = o; } } };
struct StRowF32 { float* O; int lane; __device__ __forceinline__ void operator()(int m, const f32x4 (&v)[8]) const { float* orow = O + (size_t)m * DM + 8 * lane;
#pragma unroll
    for (int j = 0; j < 4; ++j) { *(GAS f32x4*)(orow + 512 * j) = v[2 * j]; *(GAS f32x4*)(orow + 512 * j + 4) = v[2 * j + 1]; } } };
struct Side2xBf16 { bf16* O; int ldo; int lane; __device__ __forceinline__ void operator()(int m, const f32x4 (&v)[8]) const { bf16* orow = O + (size_t)m * ldo + 8 * lane;
#pragma unroll
    for (int j = 0; j < 4; ++j) { const f32x4 a = v[2 * j] * 2.0f, b = v[2 * j + 1] * 2.0f; v4u o; o.x = pk2(a.x, a.y); o.y = pk2(a.z, a.w); o.z = pk2(b.x, b.y); o.w = pk2(b.z, b.w); *(GAS v4u*)(orow + 512 * j) = o; } } };
__device__ __forceinline__ void fill_identity(Frame& F, bf16* WT, int n, int ldw, int c0) {
    const size_t nchunks = (size_t)n * (n / 8);
    for (size_t i = (size_t)F.vcu * (NWAVES * 64) + F.tid; i < nchunks; i += (size_t)F.G * NWAVES * 64) { const int row = (int)(i / (n / 8)), c = (int)(i % (n / 8)) * 8;
        v4u o = {0u, 0u, 0u, 0u}; const int d = row - c;
        if (d >= 0 && d < 8) { const unsigned one = (d & 1) ? 0x3F800000u : 0x00003F80u; if ((d >> 1) == 0) o.x = one; else if ((d >> 1) == 1) o.y = one; else if ((d >> 1) == 2) o.z = one; else o.w = one; }
        *(GAS v4u*)(WT + (size_t)row * ldw + c0 + c) = o; }
}
struct LdRowBf16T { struct Raw { v4u q[4]; }; const bf16* X; int lane;
    __device__ __forceinline__ void load(int m, Raw& w) const {
#pragma unroll
        for (int j = 0; j < 4; ++j) w.q[j] = *(const GAS v4u*)((const GAS unsigned char*)X + pg8::tiled_off(m, 512 * j + 8 * lane, DM)); }
    __device__ __forceinline__ void unpack(const Raw& w, f32x4 (&v)[8]) const {
#pragma unroll
        for (int j = 0; j < 4; ++j) { const v4u x = w.q[j]; v[2 * j] = (f32x4){pg8::bf_lo(x.x), pg8::bf_hi(x.x), pg8::bf_lo(x.y), pg8::bf_hi(x.y)}; v[2 * j + 1] = (f32x4){pg8::bf_lo(x.z), pg8::bf_hi(x.z), pg8::bf_lo(x.w), pg8::bf_hi(x.w)}; } } };
struct LdRowBf16SumT { struct Raw { v4u q[4], y[4]; }; const bf16* X; const bf16* Y; int lane;
    __device__ __forceinline__ void load(int m, Raw& w) const { const bf16* yr = Y + (size_t)m * DM + 8 * lane;
#pragma unroll
        for (int j = 0; j < 4; ++j) { w.q[j] = *(const GAS v4u*)((const GAS unsigned char*)X + pg8::tiled_off(m, 512 * j + 8 * lane, DM)); w.y[j] = *(const GAS v4u*)(yr + 512 * j); } }
    __device__ __forceinline__ void unpack(const Raw& w, f32x4 (&v)[8]) const {
#pragma unroll
        for (int j = 0; j < 4; ++j) { const v4u x = w.q[j], y = w.y[j];
            v[2 * j] = (f32x4){pg8::bf_lo(x.x) + pg8::bf_lo(y.x), pg8::bf_hi(x.x) + pg8::bf_hi(y.x), pg8::bf_lo(x.y) + pg8::bf_lo(y.y), pg8::bf_hi(x.y) + pg8::bf_hi(y.y)};
            v[2 * j + 1] = (f32x4){pg8::bf_lo(x.z) + pg8::bf_lo(y.z), pg8::bf_hi(x.z) + pg8::bf_hi(y.z), pg8::bf_lo(x.w) + pg8::bf_lo(y.w), pg8::bf_hi(x.w) + pg8::bf_hi(y.w)}; } } };
struct NoStoreRow { __device__ __forceinline__ void operator()(int, const f32x4 (&)[8]) const {} };
template <int RPW, class LOADROW, class STOREROW>
__device__ __forceinline__ void rs_pass(Frame& F, const LOADROW& ld, const STOREROW& st, float* rs) {
    const int gw = F.vcu * NWAVES + F.wave, NGW = F.G * NWAVES;
    for (int m0 = gw * RPW; m0 < M; m0 += NGW * RPW) {
        typename LOADROW::Raw raw[RPW];
#pragma unroll
        for (int r = 0; r < RPW; ++r) ld.load(m0 + r, raw[r]);
#pragma unroll
        for (int r = 0; r < RPW; ++r) { f32x4 v[8]; ld.unpack(raw[r], v); float s = 0.f;
#pragma unroll
            for (int j = 0; j < 8; ++j) s += (v[j].x * v[j].x + v[j].y * v[j].y) + (v[j].z * v[j].z + v[j].w * v[j].w);
            const float r_ = 1.0f / sqrtf(wave_sum(s) * (1.0f / DM) + NORM_EPS);
            if (F.lane == 0) rs[m0 + r] = r_;
            st(m0 + r, v); }
    }
}
__device__ __forceinline__ void rs_finalize(Frame& F, const float* part, float* rs) {
    for (int row = F.vcu * (NWAVES * 64) + F.tid; row < M; row += F.G * NWAVES * 64) { float s = 0.f;
#pragma unroll
        for (int p_ = 0; p_ < 32; ++p_) s += part[(size_t)p_ * M + row];
        rs[row] = 1.0f / sqrtf(s * (1.0f / DM) + NORM_EPS); }
}
__device__ __forceinline__ void rms_rows_bf16(Frame& F, const float* X, const float* g, bf16* O) { rms_pass<2>(F, g, LdRowF32{X, F.lane}, StRowBf16{O, F.lane}); }
template <bool OUT_F32>
__device__ __forceinline__ void rms_rows_from_bf16(Frame& F, const bf16* X, const float* g, void* Out) {
    if constexpr (OUT_F32) rms_pass<2>(F, g, LdRowBf16{X, F.lane}, StRowF32{(float*)Out, F.lane}); else rms_pass<2>(F, g, LdRowBf16{X, F.lane}, StRowBf16{(bf16*)Out, F.lane});
}
__device__ __forceinline__ void zero_rows_tiled(Frame& F, bf16* WT, int r0, int r1, int K) {
    const size_t nch = (size_t)(r1 - r0) * (K / 8);
    for (size_t i = (size_t)F.vcu * (NWAVES * 64) + F.tid; i < nch; i += (size_t)F.G * NWAVES * 64) { const int r = r0 + (int)(i / (K / 8)), c = (int)(i % (K / 8)) * 8;
        *(GAS v4u*)((GAS unsigned char*)WT + pg8::tiled_off((r & ~31) + pg8::inv_perm32(r & 31), c, K)) = (v4u){0u, 0u, 0u, 0u}; }
}
__device__ __forceinline__ void zero_rows_bf16(Frame& F, bf16* P, size_t nbytes) {
    const size_t n16 = nbytes / 16; GAS v4u* p = (GAS v4u*)P;
    for (size_t i = (size_t)F.vcu * (NWAVES * 64) + F.tid; i < n16; i += (size_t)F.G * NWAVES * 64) p[i] = (v4u){0u, 0u, 0u, 0u};
}

namespace gla {
using bf16x8 = __attribute__((ext_vector_type(8))) short;
using s16x4  = __attribute__((ext_vector_type(4))) short;
using f32x16 = __attribute__((ext_vector_type(16))) float;
using u32x4  = __attribute__((ext_vector_type(4))) unsigned;
using u32x2  = __attribute__((ext_vector_type(2))) unsigned;
constexpr int CH = 128;
constexpr int NCH = SEQ / CH;
constexpr int VSTR = 576, KSTR = 320;
constexpr int L_V = 0, L_K = 73728, L_TOT = 114688, L_PRE = 116736, L_EB = 119296, L_SS = 119808, L_END = 120832;
constexpr float LOG2E = 1.4426950408889634f, LN2 = 0.6931471805599453f, DKS = 0.08838834764831845f;
__device__ __forceinline__ int crow(int r, int hi) { return (r & 3) + 8 * (r >> 2) + 4 * hi; }
typedef float f32x2_t __attribute__((ext_vector_type(2))); typedef __bf16 bf16x2_t __attribute__((ext_vector_type(2)));
__device__ __forceinline__ unsigned cvtpk(float lo, float hi) { f32x2_t v = {lo, hi}; bf16x2_t b = __builtin_convertvector(v, bf16x2_t); return __builtin_bit_cast(unsigned, b); }
__device__ __forceinline__ float bfround(float x) { return __builtin_bit_cast(float, cvtpk(x, 0.f) << 16); }
__device__ __forceinline__ s16x4 tr_read(int addr) { s16x4 r; asm volatile("ds_read_b64_tr_b16 %0, %1" : "=&v"(r) : "v"(addr) : "memory"); return r; }
#define GLA_LWAIT() do { asm volatile("s_waitcnt lgkmcnt(0)" ::: "memory"); __builtin_amdgcn_sched_barrier(0); } while (0)
template <int CTRL, int RMASK, bool BC> __device__ __forceinline__ float dpp_mov(float v) {
    return __builtin_bit_cast(float, __builtin_amdgcn_update_dpp(0, __builtin_bit_cast(int, v), CTRL, RMASK, 0xf, BC)); }
__device__ __forceinline__ float scan32(float v) {
    v += dpp_mov<0x111, 0xf, true>(v); v += dpp_mov<0x112, 0xf, true>(v); v += dpp_mov<0x114, 0xf, true>(v); v += dpp_mov<0x118, 0xf, true>(v);
    v += dpp_mov<0x142, 0xa, false>(v);
    return v;
}
__device__ __forceinline__ bf16x8 pack8(const float* v) { u32x4 w = {cvtpk(v[0], v[1]), cvtpk(v[2], v[3]), cvtpk(v[4], v[5]), cvtpk(v[6], v[7])}; return *reinterpret_cast<bf16x8*>(&w); }
#define GLA_PK(L, H) (bf16x8){L[0], L[1], L[2], L[3], H[0], H[1], H[2], H[3]}

struct Tensors { const bf16* GQ; const bf16* GK; const bf16* GV; const bf16* GR; const float* GLR; const float* WA; const float* BA; const float* GN; bf16* ST; float* DEC; bf16* OA; bf16* KF; bf16* QF; };

__device__ __forceinline__ void unit_a(const Tensors& X, int b, int hh, int c, LAS unsigned char* lds) {
    const int tid = threadIdx.x, w = __builtin_amdgcn_readfirstlane(tid >> 6), lane = tid & 63, r = lane & 31, h = lane >> 5, pt = w & 3, dh = w >> 2;
    const size_t row0 = (size_t)b * SEQ + (size_t)c * CH, row = row0 + 32 * pt + r;
    const size_t unit_id = (size_t)(b * GLA_H + hh) * NCH + c;
#pragma unroll
    for (int i = 0; i < 8; ++i) { const int piece = tid + 512 * i, ri = piece >> 5, cj = piece & 31;
        const u32x4 v = *reinterpret_cast<const u32x4*>(X.GV + (row0 + ri) * 1024 + hh * 256 + cj * 8);
        *reinterpret_cast<LAS u32x4*>(lds + L_V + ri * VSTR + cj * 16) = v; }
    const int T0 = 2 * dh;
    u32x2 kw[2][4], qw[2][4];
#pragma unroll
    for (int t = 0; t < 2; ++t)
#pragma unroll
        for (int g = 0; g < 4; ++g) { const int ch0 = 32 * (T0 + t) + 8 * g + 4 * h;
            const size_t gi = ((size_t)((row >> 5) * 128 + ((hh * 128 + ch0) >> 2)) * 32 + (row & 31)) * 4;
            kw[t][g] = *reinterpret_cast<const u32x2*>(X.GK + gi); qw[t][g] = *reinterpret_cast<const u32x2*>(X.GQ + gi); }
    float xb[2][16];
    {
        const f32x4 g0 = *reinterpret_cast<const f32x4*>(X.GLR + row * 16 + 8 * h), g1 = *reinterpret_cast<const f32x4*>(X.GLR + row * 16 + 8 * h + 4);
        float wv[2][8]; f32x4 bb[2][4];
#pragma unroll
        for (int t = 0; t < 2; ++t) {
#pragma unroll
            for (int j = 0; j < 8; ++j) wv[t][j] = X.WA[(8 * h + j) * 512 + hh * 128 + 32 * (T0 + t) + r];
#pragma unroll
            for (int g = 0; g < 4; ++g) bb[t][g] = *reinterpret_cast<const f32x4*>(X.BA + hh * 128 + 32 * (T0 + t) + 8 * g + 4 * h); }
        const float gv[8] = {g0.x, g0.y, g0.z, g0.w, g1.x, g1.y, g1.z, g1.w}; float gh[8], gl[8];
#pragma unroll
        for (int j = 0; j < 8; ++j) { gh[j] = bfround(gv[j]); gl[j] = gv[j] - gh[j]; }
        const bf16x8 Bhi = pack8(gh), Blo = pack8(gl);
#pragma unroll
        for (int t = 0; t < 2; ++t) {
            float wh[8], wl[8];
#pragma unroll
            for (int j = 0; j < 8; ++j) { wh[j] = bfround(wv[t][j]); wl[j] = wv[t][j] - wh[j]; }
            const bf16x8 Ahi = pack8(wh), Alo = pack8(wl);
            f32x16 xt = {};
            xt = __builtin_amdgcn_mfma_f32_32x32x16_bf16(Ahi, Bhi, xt, 0, 0, 0);
            xt = __builtin_amdgcn_mfma_f32_32x32x16_bf16(Alo, Bhi, xt, 0, 0, 0);
            xt = __builtin_amdgcn_mfma_f32_32x32x16_bf16(Ahi, Blo, xt, 0, 0, 0);
#pragma unroll
            for (int g = 0; g < 4; ++g)
#pragma unroll
                for (int e = 0; e < 4; ++e) { const float xv = xt[4 * g + e] + bb[t][g][e];
                    const float ee = __builtin_amdgcn_exp2f(-fabsf(xv) * LOG2E); const float ls = fminf(xv, 0.f) - __builtin_amdgcn_logf(1.0f + ee) * LN2;
                    xb[t][4 * g + e] = scan32(ls * 0.0625f); }
        }
    }
    LAS float* tot = (LAS float*)(lds + L_TOT); LAS float* pre = (LAS float*)(lds + L_PRE); LAS float* eB = (LAS float*)(lds + L_EB);
    if (r == 31) {
#pragma unroll
        for (int t = 0; t < 2; ++t)
#pragma unroll
            for (int i = 0; i < 16; ++i) tot[pt * 128 + 32 * (T0 + t) + crow(i, h)] = xb[t][i];
    }
    __syncthreads();
    if (tid < 128) { float p = 0.f;
#pragma unroll
        for (int t = 0; t < 4; ++t) { pre[t * 128 + tid] = p; p += tot[t * 128 + tid]; }
        const float e = __builtin_amdgcn_exp2f(p * LOG2E); eB[tid] = e;
        X.DEC[unit_id * 128 + tid] = e; }
    __syncthreads();
    unsigned char* kfg = (unsigned char*)X.KF + unit_id * 32768; unsigned char* qfg = (unsigned char*)X.QF + unit_id * 32768;
#pragma unroll
    for (int t = 0; t < 2; ++t) { const int T = T0 + t; float kt[16], qt[16];
#pragma unroll
        for (int g = 0; g < 4; ++g) { const int ch0 = 32 * T + 8 * g + 4 * h;
            const f32x4 pp = *reinterpret_cast<const LAS f32x4*>(pre + pt * 128 + ch0);
            const float kv[4] = {pg8::bf_lo(kw[t][g].x), pg8::bf_hi(kw[t][g].x), pg8::bf_lo(kw[t][g].y), pg8::bf_hi(kw[t][g].y)};
            const float qv[4] = {pg8::bf_lo(qw[t][g].x), pg8::bf_hi(qw[t][g].x), pg8::bf_lo(qw[t][g].y), pg8::bf_hi(qw[t][g].y)};
#pragma unroll
            for (int e = 0; e < 4; ++e) { const float bbv = (xb[t][4 * g + e] + pp[e]) * LOG2E;
                kt[4 * g + e] = kv[e] * __builtin_amdgcn_exp2f(-bbv); qt[4 * g + e] = qv[e] * __builtin_amdgcn_exp2f(bbv) * DKS; }
            u32x2 o; o.x = cvtpk(kt[4 * g], kt[4 * g + 1]); o.y = cvtpk(kt[4 * g + 2], kt[4 * g + 3]);
            *reinterpret_cast<LAS u32x2*>(lds + L_K + (32 * pt + r) * KSTR + ch0 * 2) = o;
        }
        *reinterpret_cast<bf16x8*>(kfg + ((pt * 8 + 2 * T) * 64 + lane) * 16) = pack8(kt); *reinterpret_cast<bf16x8*>(kfg + ((pt * 8 + 2 * T + 1) * 64 + lane) * 16) = pack8(kt + 8);
        *reinterpret_cast<bf16x8*>(qfg + ((pt * 8 + 2 * T) * 64 + lane) * 16) = pack8(qt); *reinterpret_cast<bf16x8*>(qfg + ((pt * 8 + 2 * T + 1) * 64 + lane) * 16) = pack8(qt + 8);
    }
    __syncthreads();
    const int q4 = (lane & 15) >> 2, p4 = lane & 3, rhalf = (lane >> 4) & 1;
    const int d = w;
    f32x16 acc[4] = {};
    const int vbase = (int)(uintptr_t)(lds + L_V) + (8 * h + q4) * VSTR + (32 * d + 16 * rhalf + 4 * p4) * 2;
    const int kbase = (int)(uintptr_t)(lds + L_K) + (8 * h + q4) * KSTR + (16 * rhalf + 4 * p4) * 2;
    {
#define GLA_AR(s2_, v0, v1, k00, k01, k02, k03, k10, k11, k12, k13) \
        const s16x4 v0 = tr_read(vbase + (16 * (s2_)) * VSTR), v1 = tr_read(vbase + (16 * (s2_) + 4) * VSTR), \
                    k00 = tr_read(kbase + (16 * (s2_)) * KSTR), k01 = tr_read(kbase + (16 * (s2_)) * KSTR + 64), k02 = tr_read(kbase + (16 * (s2_)) * KSTR + 128), k03 = tr_read(kbase + (16 * (s2_)) * KSTR + 192), \
                    k10 = tr_read(kbase + (16 * (s2_) + 4) * KSTR), k11 = tr_read(kbase + (16 * (s2_) + 4) * KSTR + 64), k12 = tr_read(kbase + (16 * (s2_) + 4) * KSTR + 128), k13 = tr_read(kbase + (16 * (s2_) + 4) * KSTR + 192)
#define GLA_AM(v0, v1, k00, k01, k02, k03, k10, k11, k12, k13) do { const bf16x8 Bv = GLA_PK(v0, v1); \
        acc[0] = __builtin_amdgcn_mfma_f32_32x32x16_bf16(GLA_PK(k00, k10), Bv, acc[0], 0, 0, 0); acc[1] = __builtin_amdgcn_mfma_f32_32x32x16_bf16(GLA_PK(k01, k11), Bv, acc[1], 0, 0, 0); \
        acc[2] = __builtin_amdgcn_mfma_f32_32x32x16_bf16(GLA_PK(k02, k12), Bv, acc[2], 0, 0, 0); acc[3] = __builtin_amdgcn_mfma_f32_32x32x16_bf16(GLA_PK(k03, k13), Bv, acc[3], 0, 0, 0); } while (0)
#define GLA_CW(n) do { asm volatile("s_waitcnt lgkmcnt(" #n ")" ::: "memory"); __builtin_amdgcn_sched_barrier(0); } while (0)
        GLA_AR(0, p0, p1, p2, p3, p4, p5, p6, p7, p8, p9);
        GLA_AR(1, q0, q1, q2, q3, q4_, q5, q6, q7, q8, q9);   GLA_CW(10); GLA_AM(p0, p1, p2, p3, p4, p5, p6, p7, p8, p9);
        GLA_AR(2, r0, r1, r2, r3, r4, r5, r6, r7, r8, r9);    GLA_CW(10); GLA_AM(q0, q1, q2, q3, q4_, q5, q6, q7, q8, q9);
        GLA_AR(3, s0, s1, s2, s3, s4, s5, s6, s7, s8, s9);    GLA_CW(10); GLA_AM(r0, r1, r2, r3, r4, r5, r6, r7, r8, r9);
        GLA_AR(4, t0, t1, t2_, t3, t4, t5, t6, t7, t8, t9);   GLA_CW(10); GLA_AM(s0, s1, s2, s3, s4, s5, s6, s7, s8, s9);
        GLA_AR(5, u0, u1, u2, u3, u4, u5, u6, u7, u8, u9);    GLA_CW(10); GLA_AM(t0, t1, t2_, t3, t4, t5, t6, t7, t8, t9);
        GLA_AR(6, w0, w1, w2, w3, w4, w5, w6, w7, w8, w9);    GLA_CW(10); GLA_AM(u0, u1, u2, u3, u4, u5, u6, u7, u8, u9);
        GLA_AR(7, x0, x1, x2, x3, x4, x5, x6, x7, x8, x9);    GLA_CW(10); GLA_AM(w0, w1, w2, w3, w4, w5, w6, w7, w8, w9);
        GLA_CW(0); GLA_AM(x0, x1, x2, x3, x4, x5, x6, x7, x8, x9);
#undef GLA_AR
#undef GLA_AM
#undef GLA_CW
    }
    unsigned char* Lg = (unsigned char*)X.ST + unit_id * 65536;
#pragma unroll
    for (int T = 0; T < 4; ++T) { float o[16];
#pragma unroll
        for (int g = 0; g < 4; ++g) { const f32x4 sc = *reinterpret_cast<const LAS f32x4*>(eB + 32 * T + 8 * g + 4 * h);
#pragma unroll
            for (int e = 0; e < 4; ++e) o[4 * g + e] = acc[T][4 * g + e] * sc[e]; }
        *reinterpret_cast<bf16x8*>(Lg + (((d * 4 + T) * 2 + 0) * 64 + lane) * 16) = pack8(o);
        *reinterpret_cast<bf16x8*>(Lg + (((d * 4 + T) * 2 + 1) * 64 + lane) * 16) = pack8(o + 8); }
    __syncthreads();
}

__device__ __forceinline__ void unit_c(const Tensors& X, int b, int hh, int c, LAS unsigned char* lds) {
    const int tid = threadIdx.x, w = __builtin_amdgcn_readfirstlane(tid >> 6), lane = tid & 63, r = lane & 31, h = lane >> 5, pt = w & 3, dh = w >> 2;
    const size_t row0 = (size_t)b * SEQ + (size_t)c * CH, row = row0 + 32 * pt + r;
    const size_t unit_id = (size_t)(b * GLA_H + hh) * NCH + c;
#pragma unroll
    for (int i = 0; i < 8; ++i) { const int piece = tid + 512 * i, ri = piece >> 5, cj = piece & 31;
        const u32x4 v = *reinterpret_cast<const u32x4*>(X.GV + (row0 + ri) * 1024 + hh * 256 + cj * 8);
        *reinterpret_cast<LAS u32x4*>(lds + L_V + ri * VSTR + cj * 16) = v; }
    const unsigned char* kfg = (const unsigned char*)X.KF + unit_id * 32768; const unsigned char* qfg = (const unsigned char*)X.QF + unit_id * 32768;
    const unsigned char* Sg = (const unsigned char*)X.ST + unit_id * 65536;
    bf16x8 qf[8], kfa[8], kfb[8];
#pragma unroll
    for (int s = 0; s < 8; ++s) qf[s] = *reinterpret_cast<const bf16x8*>(qfg + ((pt * 8 + s) * 64 + lane) * 16);
#pragma unroll
    for (int s = 0; s < 8; ++s) kfa[s] = *reinterpret_cast<const bf16x8*>(kfg + ((0 * 8 + s) * 64 + lane) * 16);
    if (pt >= 1) {
#pragma unroll
        for (int s = 0; s < 8; ++s) kfb[s] = *reinterpret_cast<const bf16x8*>(kfg + ((1 * 8 + s) * 64 + lane) * 16); }
    f32x16 acc[4] = {};
#pragma unroll
    for (int dd = 0; dd < 4; ++dd) { const int d = 4 * dh + dd;
#pragma unroll
        for (int s = 0; s < 8; ++s) { const bf16x8 a = *reinterpret_cast<const bf16x8*>(Sg + ((d * 8 + s) * 64 + lane) * 16);
            acc[dd] = __builtin_amdgcn_mfma_f32_32x32x16_bf16(a, qf[s], acc[dd], 0, 0, 0); } }
    __syncthreads();
    const int q4 = (lane & 15) >> 2, p4 = lane & 3, rhalf = (lane >> 4) & 1;
    const int vbase = (int)(uintptr_t)(lds + L_V) + (4 * h + q4) * VSTR + (128 * dh + 16 * rhalf + 4 * p4) * 2;
    for (int t2 = 0; t2 <= pt; ++t2) {
        f32x16 st = {};
#pragma unroll
        for (int s = 0; s < 8; ++s) st = __builtin_amdgcn_mfma_f32_32x32x16_bf16(kfa[s], qf[s], st, 0, 0, 0);
#pragma unroll
        for (int s = 0; s < 8; ++s) kfa[s] = kfb[s];
        if (t2 + 2 <= pt) {
#pragma unroll
            for (int s = 0; s < 8; ++s) kfb[s] = *reinterpret_cast<const bf16x8*>(kfg + (((t2 + 2) * 8 + s) * 64 + lane) * 16); }
        if (t2 == pt) {
#pragma unroll
            for (int i = 0; i < 16; ++i) if (crow(i, h) > r) st[i] = 0.f; }
        float sv[16];
#pragma unroll
        for (int i = 0; i < 16; ++i) sv[i] = st[i];
        const bf16x8 P0 = pack8(sv), P1 = pack8(sv + 8);
        {
            const int vb = vbase + (32 * t2) * VSTR;
#define GLA_VR(dd, a0, a1, a2, a3) const s16x4 a0 = tr_read(vb + 64 * (dd)), a1 = tr_read(vb + 64 * (dd) + 8 * VSTR), a2 = tr_read(vb + 64 * (dd) + 16 * VSTR), a3 = tr_read(vb + 64 * (dd) + 24 * VSTR)
#define GLA_VM(dd, a0, a1, a2, a3) do { acc[dd] = __builtin_amdgcn_mfma_f32_32x32x16_bf16(GLA_PK(a0, a1), P0, acc[dd], 0, 0, 0); acc[dd] = __builtin_amdgcn_mfma_f32_32x32x16_bf16(GLA_PK(a2, a3), P1, acc[dd], 0, 0, 0); } while (0)
#define GLA_CW(n) do { asm volatile("s_waitcnt lgkmcnt(" #n ")" ::: "memory"); __builtin_amdgcn_sched_barrier(0); } while (0)
            GLA_VR(0, e0, e1, e2, e3); GLA_VR(1, f0, f1, f2, f3);
            GLA_CW(4); GLA_VM(0, e0, e1, e2, e3);
            GLA_VR(2, g0, g1, g2, g3);
            GLA_CW(4); GLA_VM(1, f0, f1, f2, f3);
            GLA_VR(3, h0, h1, h2, h3);
            GLA_CW(4); GLA_VM(2, g0, g1, g2, g3);
            GLA_CW(0); GLA_VM(3, h0, h1, h2, h3);
#undef GLA_VR
#undef GLA_VM
#undef GLA_CW
        }
    }
    u32x2 grv[4][4];
#pragma unroll
    for (int dd = 0; dd < 4; ++dd)
#pragma unroll
        for (int g = 0; g < 4; ++g) { const int dv = 128 * dh + 32 * dd + 8 * g + 4 * h;
            grv[dd][g] = *reinterpret_cast<const u32x2*>(X.GR + ((size_t)((row >> 5) * 256 + ((hh * 256 + dv) >> 2)) * 32 + (row & 31)) * 4); }
    float ss = 0.f;
#pragma unroll
    for (int dd = 0; dd < 4; ++dd)
#pragma unroll
        for (int i = 0; i < 16; ++i) ss += acc[dd][i] * acc[dd][i];
    ss += __shfl_xor(ss, 32);
    LAS float* SS = (LAS float*)(lds + L_SS);
    if (h == 0) SS[(pt * 2 + dh) * 32 + r] = ss;
    __syncthreads();
    const float rs = 1.0f / sqrtf((SS[(pt * 2) * 32 + r] + SS[(pt * 2 + 1) * 32 + r]) * (1.0f / 256.0f) + NORM_EPS);
#pragma unroll
    for (int dd = 0; dd < 4; ++dd)
#pragma unroll
        for (int g = 0; g < 4; ++g) { const int dv = 128 * dh + 32 * dd + 8 * g + 4 * h;
            const f32x4 gn = *reinterpret_cast<const f32x4*>(X.GN + dv);
            const u32x2 gr = grv[dd][g];
            const float o0 = acc[dd][4 * g] * rs * gn.x * pg8::bf_lo(gr.x), o1 = acc[dd][4 * g + 1] * rs * gn.y * pg8::bf_hi(gr.x);
            const float o2 = acc[dd][4 * g + 2] * rs * gn.z * pg8::bf_lo(gr.y), o3 = acc[dd][4 * g + 3] * rs * gn.w * pg8::bf_hi(gr.y);
            u32x2 o; o.x = cvtpk(o0, o1); o.y = cvtpk(o2, o3);
            *reinterpret_cast<u32x2*>((unsigned char*)X.OA + pg8::tiled_off((int)row, hh * 256 + dv, 1024)) = o; }
    __syncthreads();
}
}

template <bool PASS_C>
__device__ __forceinline__ void gla_pass(Frame& F, const gla::Tensors& X) {
    for (int u = F.vcu; u < BATCH * GLA_H * gla::NCH; u += F.G) { if (PASS_C) gla::unit_c(X, u >> 8, (u >> 6) & 3, u & 63, F.lds + RING_OFF); else gla::unit_a(X, u >> 8, (u >> 6) & 3, u & 63, F.lds + RING_OFF); }
}
__device__ __forceinline__ void gla_scan(Frame& F, const gla::Tensors& X) {
    using gla::u32x2;
    const int gt = F.vcu * (NWAVES * 64) + F.tid;
    for (int e = gt; e < BATCH * GLA_H * 8192; e += F.G * NWAVES * 64) {
        const int bh = e >> 13, hp = e & 8191, piece = hp >> 1, j4 = hp & 1, lane = piece & 63, pu = piece >> 6, u = pu & 1, T = (pu >> 1) & 3;
        const int ch0 = 32 * T + 16 * u + 4 * (lane >> 5) + 8 * j4;
        unsigned char* base = (unsigned char*)X.ST + (size_t)bh * gla::NCH * 65536 + (size_t)piece * 16 + j4 * 8;
        const float* dec = X.DEC + (size_t)bh * gla::NCH * 128 + ch0;
        float s0 = 0.f, s1 = 0.f, s2 = 0.f, s3 = 0.f;
#pragma unroll 8
        for (int c = 0; c < gla::NCH; ++c) {
            const u32x2 l = *reinterpret_cast<const u32x2*>(base + (size_t)c * 65536);
            const f32x4 dc = *reinterpret_cast<const f32x4*>(dec + c * 128);
            u32x2 o; o.x = gla::cvtpk(s0, s1); o.y = gla::cvtpk(s2, s3);
            *reinterpret_cast<u32x2*>(base + (size_t)c * 65536) = o;
            s0 = fmaf(dc.x, s0, pg8::bf_lo(l.x)); s1 = fmaf(dc.y, s1, pg8::bf_hi(l.x)); s2 = fmaf(dc.z, s2, pg8::bf_lo(l.y)); s3 = fmaf(dc.w, s3, pg8::bf_hi(l.y));
        }
    }
}

namespace moba {
using bf16x8 = __attribute__((ext_vector_type(8))) short;
using s16x4  = __attribute__((ext_vector_type(4))) short;
using f32x16 = __attribute__((ext_vector_type(16))) float;
using u32x4  = __attribute__((ext_vector_type(4))) unsigned;
constexpr int D = 128, NW = 8, QBLK = 32, KVBLK = 64, LDQ = 1024, LDK = 1024, LDO = 1024;
constexpr float SCALE = 0.088388347648318440f, LOG2E = 1.4426950408889634f, C = SCALE * LOG2E;
constexpr int SDEPTH = 1;
constexpr float THRL = 8.f * LOG2E;
constexpr size_t SHM_V = KVBLK * D * 2, SHM_K = KVBLK * D * 2, SHM_Q = 2 * SHM_V + 2 * SHM_K + NW * 64 * 4, SHM_ATTN = SHM_Q + 65536;
#define KSWZ(row, colB) ((row) * 256 + ((colB) ^ (((row) & 7) << 4)))
#define SBAR() __builtin_amdgcn_sched_barrier(0)
__device__ __forceinline__ int crow(int r, int hi) { return (r & 3) + 8 * (r >> 2) + 4 * hi; }
__device__ __forceinline__ unsigned cvtpk(float lo, float hi) { unsigned r; asm volatile("v_cvt_pk_bf16_f32 %0, %1, %2" : "=v"(r) : "v"(lo), "v"(hi)); return r; }

__device__ __forceinline__ void bias_init(f32x16& p0, f32x16& p1, float lbc, float sl2c) {
#pragma unroll
  for (int r = 0; r < 16; ++r) { const int cr = (r & 3) + 8 * (r >> 2); p0[r] = fmaf(sl2c, (float)cr, lbc); p1[r] = fmaf(sl2c, (float)(cr + 32), lbc); }
}
template <bool CAUSAL>
__device__ __forceinline__ void partialSM(f32x16& p0, f32x16& p1, float& m_reg, float& mn, float& alpha, int dk) {
  if (CAUSAL) {
#pragma unroll
    for (int r = 0; r < 16; ++r) { const int cr = (r & 3) + 8 * (r >> 2); if (cr + dk > 0) p0[r] = -INFINITY; if (cr + 32 + dk > 0) p1[r] = -INFINITY; } }
  float pmax = p0[0];
#pragma unroll
  for (int r = 1; r < 16; ++r) pmax = fmaxf(pmax, p0[r]);
#pragma unroll
  for (int r = 0; r < 16; ++r) pmax = fmaxf(pmax, p1[r]);
  { auto rr = __builtin_amdgcn_permlane32_swap(__float_as_uint(pmax), __float_as_uint(pmax), false, false);
    pmax = fmaxf(__uint_as_float(rr[0]), __uint_as_float(rr[1])); }
  if (__builtin_expect(__all(pmax - m_reg <= THRL / C), 1)) { mn = m_reg; alpha = 1.f; }
  else { mn = fmaxf(m_reg, pmax); alpha = __builtin_amdgcn_exp2f((m_reg - mn) * C); m_reg = mn; }
  const float mnC = -mn * C;
#pragma unroll
  for (int r = 0; r < 16; ++r) { p0[r] = __builtin_amdgcn_exp2f(fmaf(p0[r], C, mnC)); p1[r] = fmaf(p1[r], C, mnC); }
}
__device__ __forceinline__ void finishSM(f32x16& p0, f32x16& p1, float alpha, float& l_reg, bf16x8& pa0, bf16x8& pa1, bf16x8& pa2, bf16x8& pa3) {
#pragma unroll
  for (int r = 0; r < 16; ++r) p1[r] = __builtin_amdgcn_exp2f(p1[r]);
  float ps = 0;
#pragma unroll
  for (int r = 0; r < 16; ++r) ps += p0[r];
#pragma unroll
  for (int r = 0; r < 16; ++r) ps += p1[r];
  { auto rr = __builtin_amdgcn_permlane32_swap(__float_as_uint(ps), __float_as_uint(ps), false, false);
    ps = __uint_as_float(rr[0]) + __uint_as_float(rr[1]); }
  l_reg = l_reg * alpha + ps;
#define PK4(P, BASE, OUT) do { unsigned a0 = cvtpk(P[BASE + 0], P[BASE + 1]), a1 = cvtpk(P[BASE + 2], P[BASE + 3]);   \
    unsigned b0 = cvtpk(P[BASE + 4], P[BASE + 5]), b1 = cvtpk(P[BASE + 6], P[BASE + 7]);                              \
    auto r0 = __builtin_amdgcn_permlane32_swap(a0, b0, false, false); auto r1 = __builtin_amdgcn_permlane32_swap(a1, b1, false, false); \
    u32x4 w = {r0[0], r1[0], r0[1], r1[1]}; OUT = *reinterpret_cast<bf16x8*>(&w); } while (0)
  PK4(p0, 0, pa0); PK4(p0, 8, pa1); PK4(p1, 0, pa2); PK4(p1, 8, pa3);
#undef PK4
}
__device__ __forceinline__ void qkt(f32x16& p0, f32x16& p1, const LAS unsigned char* Ks, const LAS unsigned char* qf, int r32, int hi) {
#pragma unroll
  for (int d0 = 0; d0 < 8; ++d0) { int cb = (d0 * 16 + hi * 8) * 2;
    bf16x8 b0 = *reinterpret_cast<const LAS bf16x8*>(Ks + KSWZ(r32, cb));
    bf16x8 b1 = *reinterpret_cast<const LAS bf16x8*>(Ks + KSWZ(32 + r32, cb));
    bf16x8 q = *reinterpret_cast<const LAS bf16x8*>(qf + d0 * 1024);
    p0 = __builtin_amdgcn_mfma_f32_32x32x16_bf16(b0, q, p0, 0, 0, 0);
    p1 = __builtin_amdgcn_mfma_f32_32x32x16_bf16(b1, q, p1, 0, 0, 0); }
}
__device__ __forceinline__ int v_st(int k, int c) { const int kk = (k & ~0xC) | ((k & 4) << 1) | ((k & 8) >> 1); return ((kk >> 3) * 4 + (c >> 5)) * 512 + ((kk & 7) * 32 + (c & 31)) * 2; }
__device__ __forceinline__ int v_rd_base(int lane) { return ((lane & 3) << 3) | (((lane >> 2) & 3) << 6) | (((lane >> 4) & 1) << 5) | (((lane >> 5) & 1) << 8); }
constexpr int v_rd_off(int d0, int ks, int half) { return d0 * 512 + ks * 4096 + half * 2048; }
template <int OFF> __device__ __forceinline__ s16x4 tr_read(int vb) {
  s16x4 r; asm volatile("ds_read_b64_tr_b16 %0, %1 offset:%2" : "=&v"(r) : "v"(vb), "i"(OFF) : "memory"); return r;
}
#define PV_READS(D0, l0, h0, l1, h1, l2, h2, l3, h3) \
  const s16x4 l0 = tr_read<v_rd_off(D0, 0, 0)>(vb), h0 = tr_read<v_rd_off(D0, 0, 1)>(vb), l1 = tr_read<v_rd_off(D0, 1, 0)>(vb), h1 = tr_read<v_rd_off(D0, 1, 1)>(vb), \
              l2 = tr_read<v_rd_off(D0, 2, 0)>(vb), h2 = tr_read<v_rd_off(D0, 2, 1)>(vb), l3 = tr_read<v_rd_off(D0, 3, 0)>(vb), h3 = tr_read<v_rd_off(D0, 3, 1)>(vb)
#define PV_PK(L, H) (bf16x8){L[0], L[1], L[2], L[3], H[0], H[1], H[2], H[3]}
#define PV_MMA(od, l0, h0, l1, h1, l2, h2, l3, h3) do { \
  od = __builtin_amdgcn_mfma_f32_32x32x16_bf16(pa0, PV_PK(l0, h0), od, 0, 0, 0); od = __builtin_amdgcn_mfma_f32_32x32x16_bf16(pa1, PV_PK(l1, h1), od, 0, 0, 0); \
  od = __builtin_amdgcn_mfma_f32_32x32x16_bf16(pa2, PV_PK(l2, h2), od, 0, 0, 0); od = __builtin_amdgcn_mfma_f32_32x32x16_bf16(pa3, PV_PK(l3, h3), od, 0, 0, 0); } while (0)
__device__ __forceinline__ void pv_d0(f32x16* o, int vb, bf16x8 pa0, bf16x8 pa1, bf16x8 pa2, bf16x8 pa3) {
  PV_READS(0, a0, a1, a2, a3, a4, a5, a6, a7);
  PV_READS(1, b0, b1, b2, b3, b4, b5, b6, b7);
  asm volatile("s_waitcnt lgkmcnt(8)" ::: "memory"); SBAR();
  PV_MMA(o[0], a0, a1, a2, a3, a4, a5, a6, a7);
  PV_READS(2, c0, c1, c2, c3, c4, c5, c6, c7);
  asm volatile("s_waitcnt lgkmcnt(8)" ::: "memory"); SBAR();
  PV_MMA(o[1], b0, b1, b2, b3, b4, b5, b6, b7);
  PV_READS(3, d0, d1, d2, d3, d4, d5, d6, d7);
  asm volatile("s_waitcnt lgkmcnt(8)" ::: "memory"); SBAR();
  PV_MMA(o[2], c0, c1, c2, c3, c4, c5, c6, c7);
  asm volatile("s_waitcnt lgkmcnt(0)" ::: "memory"); SBAR();
  PV_MMA(o[3], d0, d1, d2, d3, d4, d5, d6, d7);
}
#undef PV_READS
#undef PV_PK
#undef PV_MMA

template <int D0> __device__ __forceinline__ void pv_one_lite(f32x16& od, int vb, bf16x8 pa0, bf16x8 pa1, bf16x8 pa2, bf16x8 pa3) {
  const s16x4 l0 = tr_read<v_rd_off(D0, 0, 0)>(vb), h0 = tr_read<v_rd_off(D0, 0, 1)>(vb), l1 = tr_read<v_rd_off(D0, 1, 0)>(vb), h1 = tr_read<v_rd_off(D0, 1, 1)>(vb);
  const s16x4 l2 = tr_read<v_rd_off(D0, 2, 0)>(vb), h2 = tr_read<v_rd_off(D0, 2, 1)>(vb), l3 = tr_read<v_rd_off(D0, 3, 0)>(vb), h3 = tr_read<v_rd_off(D0, 3, 1)>(vb);
  asm volatile("s_waitcnt lgkmcnt(0)" ::: "memory"); SBAR();
#define PK(L, H) (bf16x8){L[0], L[1], L[2], L[3], H[0], H[1], H[2], H[3]}
  od = __builtin_amdgcn_mfma_f32_32x32x16_bf16(pa0, PK(l0, h0), od, 0, 0, 0);
  od = __builtin_amdgcn_mfma_f32_32x32x16_bf16(pa1, PK(l1, h1), od, 0, 0, 0);
  od = __builtin_amdgcn_mfma_f32_32x32x16_bf16(pa2, PK(l2, h2), od, 0, 0, 0);
  od = __builtin_amdgcn_mfma_f32_32x32x16_bf16(pa3, PK(l3, h3), od, 0, 0, 0);
#undef PK
}
__device__ __forceinline__ void pv_d0_lite(f32x16* o, int vb, bf16x8 pa0, bf16x8 pa1, bf16x8 pa2, bf16x8 pa3) {
  pv_one_lite<0>(o[0], vb, pa0, pa1, pa2, pa3); pv_one_lite<1>(o[1], vb, pa0, pa1, pa2, pa3); pv_one_lite<2>(o[2], vb, pa0, pa1, pa2, pa3); pv_one_lite<3>(o[3], vb, pa0, pa1, pa2, pa3);
}

struct PartBufs { bf16* po; float* pm; float* pl; };
__device__ __forceinline__ size_t slot_off(int slot) { return slot == 0 ? (size_t)0 : (slot == 1 ? (size_t)(R1_GV / 2) : (size_t)((WS_GLAS - WS_R1) / 2)); }
__device__ __forceinline__ void unit(const bf16* __restrict__ Qb, const bf16* __restrict__ Kh, const bf16* __restrict__ Vh, bf16* __restrict__ Ob,
                                     const unsigned* __restrict__ selrow, const PartBufs& PB, size_t prow0, int qi, float sl2, LAS unsigned char* lds, int orow0, int ocol0) {
  const int tid = threadIdx.x, wid = tid >> 6, lane = tid & 63, r32 = lane & 31, hi = lane >> 5;
  LAS unsigned char* V_lds = lds; LAS unsigned char* K_lds = lds + 2 * SHM_V;
  LAS float* ws = (LAS float*)(lds + 2 * SHM_V + 2 * SHM_K) + wid * 64; LAS float* li_l = ws; LAS float* al_l = ws + 32;
  float m_reg = -1e30f, l_reg = 0; f32x16 o[4] = {};
  LAS unsigned char* qr = lds + SHM_Q + wid * 8192 + lane * 16;
  const int qrel = wid * QBLK + r32, tq = qi * 256 + qrel;
  const bf16* Qw = Qb + (long)qrel * LDQ + hi * 8;
#pragma unroll
  for (int d0 = 0; d0 < 8; ++d0) *reinterpret_cast<LAS bf16x8*>(qr + d0 * 1024) = *reinterpret_cast<const bf16x8*>(Qw + d0 * 16);
  const int sr = tid >> 4, sc = (tid & 15) * 8, vst0 = v_st(sr, sc), vst1 = v_st(32 + sr, sc);
  const int vb0 = (int)(uintptr_t)V_lds + v_rd_base(lane);
  struct { bf16x8 vs0, vs1, ks0, ks1; } sr_[SDEPTH];
  constexpr int NT = 4;
#define KT(t) (4 * qi + (t))
#define SLOAD(i, t) do { const int k0_ = KT(t) * KVBLK; sr_[i].vs0 = *reinterpret_cast<const bf16x8*>(&Vh[(long)(k0_ + sr) * LDK + sc]); sr_[i].vs1 = *reinterpret_cast<const bf16x8*>(&Vh[(long)(k0_ + 32 + sr) * LDK + sc]); \
    sr_[i].ks0 = *reinterpret_cast<const bf16x8*>(&Kh[(long)(k0_ + sr) * LDK + sc]); sr_[i].ks1 = *reinterpret_cast<const bf16x8*>(&Kh[(long)(k0_ + 32 + sr) * LDK + sc]); } while (0)
#define SWRITE(b, i) do { *(LAS bf16x8*)(V_lds + (b) * SHM_V + vst0) = sr_[i].vs0;          \
    *(LAS bf16x8*)(V_lds + (b) * SHM_V + vst1) = sr_[i].vs1; int kc = sc * 2;               \
    *(LAS bf16x8*)(K_lds + (b) * SHM_K + KSWZ(sr, kc)) = sr_[i].ks0;                       \
    *(LAS bf16x8*)(K_lds + (b) * SHM_K + KSWZ(32 + sr, kc)) = sr_[i].ks1; } while (0)
#define SWAIT() do { if (SDEPTH == 2) asm volatile("s_waitcnt vmcnt(4)" ::: "memory"); else asm volatile("s_waitcnt vmcnt(0)" ::: "memory"); } while (0)
#define RESC(a) do { if (__any((a) < 1.f)) { if (hi == 0) al_l[r32] = (a); asm volatile("s_waitcnt lgkmcnt(0)" ::: "memory"); \
    _Pragma("unroll") for (int d = 0; d < 4; ++d) _Pragma("unroll") for (int r = 0; r < 16; ++r) o[d][r] *= al_l[crow(r, hi)]; } } while (0)
#define PSM(P0, P1, MN, AL, t) do { const int dk_ = KT(t) * KVBLK + 4 * hi - tq; partialSM<true>(P0, P1, m_reg, MN, AL, dk_); } while (0)
#define QKT(P0, P1, KS, t) do { const int dk_ = KT(t) * KVBLK + 4 * hi - tq; bias_init(P0, P1, sl2c * (float)dk_, sl2c); qkt(P0, P1, KS, qr, r32, hi); } while (0)
  f32x16 pA0, pA1, pB0, pB1; float mnA, mnB, alA, alB; bf16x8 pa0, pa1, pa2, pa3;
  constexpr int SE = 0, SO = SDEPTH - 1;
  SLOAD(SE, 0); asm volatile("s_waitcnt vmcnt(0)" ::: "memory"); SWRITE(0, SE); __syncthreads();
  const float sl2c = sl2 * (1.0f / C);
  QKT(pA0, pA1, K_lds, 0); PSM(pA0, pA1, mnA, alA, 0);
  SLOAD(SO, 1); if (SDEPTH == 2) { if (2 < NT) SLOAD(SE, 2); }
  SWAIT(); SWRITE(1, SO); __syncthreads();
  for (int j = 1; j + 1 < NT; j += 2) {
    SBAR(); QKT(pB0, pB1, K_lds + SHM_K, j);
    finishSM(pA0, pA1, alA, l_reg, pa0, pa1, pa2, pa3); SBAR();
    SLOAD(SO, j + SDEPTH); SBAR();
    pv_d0(o, vb0, pa0, pa1, pa2, pa3); PSM(pB0, pB1, mnB, alB, j);
    __syncthreads(); SWAIT(); SWRITE(0, SE);
    RESC(alB); __syncthreads();
    SBAR(); QKT(pA0, pA1, K_lds, j + 1);
    finishSM(pB0, pB1, alB, l_reg, pa0, pa1, pa2, pa3); SBAR();
    if (SDEPTH == 1 || j + 3 < NT) SLOAD(SE, j + 1 + SDEPTH); SBAR();
    pv_d0(o, vb0 + (int)SHM_V, pa0, pa1, pa2, pa3); PSM(pA0, pA1, mnA, alA, j + 1);
    __syncthreads(); SWAIT(); SWRITE(1, SO);
    RESC(alA); __syncthreads();
  }
  SBAR(); QKT(pB0, pB1, K_lds + SHM_K, NT - 1);
  finishSM(pA0, pA1, alA, l_reg, pa0, pa1, pa2, pa3); SBAR();
  pv_d0(o, vb0, pa0, pa1, pa2, pa3); PSM(pB0, pB1, mnB, alB, NT - 1);
  __syncthreads(); RESC(alB);
  finishSM(pB0, pB1, alB, l_reg, pa0, pa1, pa2, pa3); SBAR();
  pv_d0(o, vb0 + (int)SHM_V, pa0, pa1, pa2, pa3);
  { int t2 = threadIdx.x; asm volatile("" : "+v"(t2));
    const int wid2 = t2 >> 6, lane2 = t2 & 63, r2 = lane2 & 31, hi2 = lane2 >> 5, qrel2 = wid2 * QBLK + r2;
    const unsigned selm2 = selrow[qrel2];
    const int nsel = __builtin_popcount(selm2); const size_t pq = prow0 + (size_t)qrel2;
    float mp[3], lp[3];
#pragma unroll
    for (int s_ = 0; s_ < 3; ++s_) { const bool ok = s_ < nsel; mp[s_] = ok ? PB.pm[(size_t)s_ * (32 * 8192) + pq] : -INFINITY; lp[s_] = ok ? PB.pl[(size_t)s_ * (32 * 8192) + pq] : 0.f; }
    const float mo = m_reg * C;
    const float Mx = fmaxf(fmaxf(mo, mp[0]), fmaxf(mp[1], mp[2]));
    const float wo = __builtin_amdgcn_exp2f(mo - Mx), w0 = lp[0] * __builtin_amdgcn_exp2f(mp[0] - Mx), w1 = lp[1] * __builtin_amdgcn_exp2f(mp[1] - Mx), w2 = lp[2] * __builtin_amdgcn_exp2f(mp[2] - Mx);
    const float rL = __builtin_amdgcn_rcpf(l_reg * wo + (w0 + w1 + w2));
    LAS float* mg = (LAS float*)(lds + SHM_Q + wid2 * 8192);
    if (hi2 == 0) { mg[r2] = wo * rL; mg[32 + r2] = w0 * rL; mg[64 + r2] = w1 * rL; mg[96 + r2] = w2 * rL; }
    asm volatile("s_waitcnt lgkmcnt(0)" ::: "memory");
#pragma unroll
    for (int r = 0; r < 16; ++r) { const int orow = crow(r, hi2);
      const float a = mg[orow], c0 = mg[32 + orow], c1 = mg[64 + orow], c2 = mg[96 + orow];
      const size_t pr = (prow0 + (size_t)(wid2 * QBLK + orow)) * 128 + r2;
      unsigned short q0[4], q1[4], q2[4];
#pragma unroll
      for (int d0 = 0; d0 < 4; ++d0) { q0[d0] = PB.po[slot_off(0) + pr + d0 * 32]; q1[d0] = PB.po[slot_off(1) + pr + d0 * 32]; q2[d0] = PB.po[slot_off(2) + pr + d0 * 32]; }
#pragma unroll
      for (int d0 = 0; d0 < 4; ++d0) { float v = o[d0][r] * a;
        const float f0 = fmaf(pg8::bf_lo((unsigned)q0[d0]), c0, v); v = c0 > 0.f ? f0 : v;
        const float f1 = fmaf(pg8::bf_lo((unsigned)q1[d0]), c1, v); v = c1 > 0.f ? f1 : v;
        const float f2 = fmaf(pg8::bf_lo((unsigned)q2[d0]), c2, v); v = c2 > 0.f ? f2 : v;
        *(bf16*)((unsigned char*)Ob + pg8::tiled_off(orow0 + wid2 * QBLK + orow, ocol0 + d0 * 32 + r2, 1024)) = (bf16)pg8::cvt_pk_bf16(v, 0.f); } } }
  __syncthreads();
#undef KT
#undef SLOAD
#undef SWRITE
#undef SWAIT
#undef RESC
#undef PSM
#undef QKT
}

constexpr int P_K = 0, P_V = 65536, P_LIST = 131072, P_GCNT = P_LIST + 15872, P_GOFF = P_GCNT + 512, P_TOT = P_GOFF + 512, P_BOX = P_TOT + 16, P_WS = P_BOX + 16, P_END = P_WS + NW * 256;
__device__ __forceinline__ void qkt_r(f32x16& p0, f32x16& p1, const LAS unsigned char* Ks, const bf16x8* qr, int r32, int hi) {
#pragma unroll
  for (int d0 = 0; d0 < 8; ++d0) { int cb = (d0 * 16 + hi * 8) * 2;
    bf16x8 b0 = *reinterpret_cast<const LAS bf16x8*>(Ks + KSWZ(r32, cb));
    bf16x8 b1 = *reinterpret_cast<const LAS bf16x8*>(Ks + KSWZ(32 + r32, cb));
    p0 = __builtin_amdgcn_mfma_f32_32x32x16_bf16(b0, qr[d0], p0, 0, 0, 0);
    p1 = __builtin_amdgcn_mfma_f32_32x32x16_bf16(b1, qr[d0], p1, 0, 0, 0); }
}
__device__ __forceinline__ void partial_unit(const bf16* __restrict__ MQ, const bf16* __restrict__ MK, const bf16* __restrict__ MV, const unsigned* __restrict__ SEL,
                                             const PartBufs& PB, int b, int h, int j, LAS unsigned char* lds) {
  const int tid = threadIdx.x, wid = __builtin_amdgcn_readfirstlane(tid >> 6), lane = tid & 63, r32 = lane & 31, hi = lane >> 5;
  const int bh = b * 8 + h, t0 = 256 * (j + 1), ngroups = 4 * (31 - j);
  const float sl2c = __builtin_amdgcn_exp2f(-(float)(h + 1)) * LOG2E * (1.0f / C);
  LAS unsigned* gcnt = (LAS unsigned*)(lds + P_GCNT); LAS unsigned* goff = (LAS unsigned*)(lds + P_GOFF); LAS unsigned* totp = (LAS unsigned*)(lds + P_TOT);
  LAS unsigned short* list = (LAS unsigned short*)(lds + P_LIST);
  const unsigned* selb = SEL + (size_t)bh * 8192 + t0;
  unsigned sw[16];
#pragma unroll
  for (int i = 0; i < 16; ++i) { const int g = wid + NW * i; sw[i] = g < ngroups ? selb[64 * g + lane] : 0u; }
  { const bf16* Kh = MK + ((size_t)b * 8192 + 256 * j) * LDK + h * 128; const bf16* Vh = MV + ((size_t)b * 8192 + 256 * j) * LDK + h * 128;
    const int sr = tid >> 4, sc = (tid & 15) * 8, vst0 = v_st(sr, sc), vst1 = v_st(32 + sr, sc), kc = sc * 2;
    bf16x8 kk[8], vv[8];
#pragma unroll
    for (int q = 0; q < 8; ++q) { const int row = (q >> 1) * 64 + (q & 1) * 32 + sr;
      kk[q] = *reinterpret_cast<const bf16x8*>(Kh + (size_t)row * LDK + sc); vv[q] = *reinterpret_cast<const bf16x8*>(Vh + (size_t)row * LDK + sc); }
#pragma unroll
    for (int q = 0; q < 8; ++q) { const int kt = q >> 1, rr = (q & 1) * 32 + sr;
      *(LAS bf16x8*)(lds + P_K + kt * 16384 + KSWZ(rr, kc)) = kk[q];
      *(LAS bf16x8*)(lds + P_V + kt * 16384 + ((q & 1) ? vst1 : vst0)) = vv[q]; } }
#pragma unroll
  for (int i = 0; i < 16; ++i) { const int g = wid + NW * i; const unsigned long long bal = __ballot((sw[i] >> j) & 1u);
    if (g < ngroups && lane == 0) gcnt[g] = (unsigned)__builtin_popcountll(bal); }
  __syncthreads();
  if (wid == 0) {
    const unsigned c0 = (2 * lane < ngroups) ? gcnt[2 * lane] : 0u, c1 = (2 * lane + 1 < ngroups) ? gcnt[2 * lane + 1] : 0u;
    unsigned x = c0 + c1;
#pragma unroll
    for (int o = 1; o < 64; o <<= 1) { const unsigned y = __shfl_up(x, o); if (lane >= o) x += y; }
    const unsigned ex = x - (c0 + c1);
    goff[2 * lane] = ex; goff[2 * lane + 1] = ex + c0;
    if (lane == 63) totp[0] = x; }
  __syncthreads();
#pragma unroll
  for (int i = 0; i < 16; ++i) { const int g = wid + NW * i; const bool pick = (sw[i] >> j) & 1u; const unsigned long long bal = __ballot(pick);
    const unsigned pos = __builtin_amdgcn_mbcnt_hi((unsigned)(bal >> 32), __builtin_amdgcn_mbcnt_lo((unsigned)bal, 0u));
    if (g < ngroups && pick) list[goff[g] + pos] = (unsigned short)((64 * g + lane) | (__builtin_popcount(sw[i] & ((1u << j) - 1u)) << 13)); }
  __syncthreads();
  const int total = (int)totp[0], ntiles = (total + 31) >> 5;
  LAS float* ws = (LAS float*)(lds + P_WS) + wid * 64; LAS float* li_l = ws; LAS float* al_l = ws + 32;
  const int vb0 = (int)(uintptr_t)(lds + P_V) + v_rd_base(lane);
#define LOADQ(E, Q, T) do { const int b_ = (T) * 32, v_ = (total - b_) < 32 ? (total - b_) : 32; E = list[b_ + (r32 < v_ ? r32 : v_ - 1)]; \
    const bf16* Qw_ = MQ + ((size_t)b * 8192 + t0 + (int)(E & 8191u)) * LDQ + h * 128 + hi * 8; \
    _Pragma("unroll") for (int d0 = 0; d0 < 8; ++d0) Q[d0] = *reinterpret_cast<const bf16x8*>(Qw_ + d0 * 16); } while (0)
  unsigned e = 0u; bf16x8 qr[8];
  if (wid < ntiles) LOADQ(e, qr, wid);
  for (int tile = wid; tile < ntiles; tile += NW) {
    const int base = tile * 32, valid = (total - base) < 32 ? (total - base) : 32;
    const int tq = t0 + (int)(e & 8191u);
    unsigned en = 0u;
    const bool more = tile + NW < ntiles;
    float m_reg = -1e30f, l_reg = 0.f; f32x16 o[4] = {};
    {
      f32x16 pA0, pA1, pB0, pB1; float mnA, mnB, alA, alB; bf16x8 pa0, pa1, pa2, pa3;
      const int dk0 = 256 * j + 4 * hi - tq;
#define PT_QK(P0, P1, kt) do { bias_init(P0, P1, sl2c * (float)(dk0 + 64 * (kt)), sl2c); qkt_r(P0, P1, lds + P_K + (kt) * 16384, qr, r32, hi); } while (0)
#define PT_RESC(a) do { if (__any((a) < 1.f)) { if (hi == 0) al_l[r32] = (a); asm volatile("s_waitcnt lgkmcnt(0)" ::: "memory"); \
        _Pragma("unroll") for (int d = 0; d < 4; ++d) _Pragma("unroll") for (int r = 0; r < 16; ++r) o[d][r] *= al_l[crow(r, hi)]; } } while (0)
      PT_QK(pA0, pA1, 0); partialSM<false>(pA0, pA1, m_reg, mnA, alA, dk0);
      PT_QK(pB0, pB1, 1); finishSM(pA0, pA1, alA, l_reg, pa0, pa1, pa2, pa3); SBAR();
      pv_d0_lite(o, vb0, pa0, pa1, pa2, pa3); partialSM<false>(pB0, pB1, m_reg, mnB, alB, dk0 + 64); PT_RESC(alB);
      PT_QK(pA0, pA1, 2); finishSM(pB0, pB1, alB, l_reg, pa0, pa1, pa2, pa3); SBAR();
      pv_d0_lite(o, vb0 + 16384, pa0, pa1, pa2, pa3); partialSM<false>(pA0, pA1, m_reg, mnA, alA, dk0 + 128); PT_RESC(alA);
      PT_QK(pB0, pB1, 3);
      if (more) LOADQ(en, qr, tile + NW);
      finishSM(pA0, pA1, alA, l_reg, pa0, pa1, pa2, pa3); SBAR();
      pv_d0_lite(o, vb0 + 2 * 16384, pa0, pa1, pa2, pa3); partialSM<false>(pB0, pB1, m_reg, mnB, alB, dk0 + 192); PT_RESC(alB);
      finishSM(pB0, pB1, alB, l_reg, pa0, pa1, pa2, pa3); SBAR();
      pv_d0_lite(o, vb0 + 3 * 16384, pa0, pa1, pa2, pa3);
#undef PT_QK
#undef PT_RESC
    }
    if (hi == 0) li_l[r32] = l_reg; asm volatile("s_waitcnt lgkmcnt(0)" ::: "memory");
    if (hi == 0 && r32 < valid) { const size_t pq = (size_t)(e >> 13) * (32 * 8192) + (size_t)bh * 8192 + tq; PB.pm[pq] = m_reg * C; PB.pl[pq] = l_reg; }
#pragma unroll
    for (int r = 0; r < 16; ++r) { const int orow = crow(r, hi);
      if (orow < valid) { const unsigned er = list[base + orow]; const float rl = __builtin_amdgcn_rcpf(li_l[orow]);
        bf16* dst = PB.po + slot_off((int)(er >> 13)) + ((size_t)bh * 8192 + t0 + (er & 8191u)) * 128 + r32;
#pragma unroll
        for (int d0 = 0; d0 < 4; ++d0) dst[d0 * 32] = (bf16)pg8::cvt_pk_bf16(o[d0][r] * rl, 0.f); } }
    if (more) e = en;
  }
#undef LOADQ
  __syncthreads();
}
#undef KSWZ
#undef SBAR
}

__device__ __forceinline__ void moba_kmean_phase(Frame& F, const bf16* MK, float* kmean) {
    LAS float* red = (LAS float*)(F.lds + RING_OFF);
    for (int u = F.vcu; u < BATCH * MOBA_NB * 2; u += F.G) {
        const int half = u & 1, bj = u >> 1;
        const int ct = F.tid & 63, rg = F.tid >> 6;
        const pg8::u32x4* src = (const pg8::u32x4*)(MK + (size_t)(bj * 256 + rg * 32) * 1024 + half * 512 + ct * 8);
        float s[8] = {0.f, 0.f, 0.f, 0.f, 0.f, 0.f, 0.f, 0.f};
#pragma unroll 16
        for (int r = 0; r < 32; ++r) { const pg8::u32x4 w = src[(size_t)r * 128];
            s[0] += pg8::bf_lo(w.x); s[1] += pg8::bf_hi(w.x); s[2] += pg8::bf_lo(w.y); s[3] += pg8::bf_hi(w.y); s[4] += pg8::bf_lo(w.z); s[5] += pg8::bf_hi(w.z); s[6] += pg8::bf_lo(w.w); s[7] += pg8::bf_hi(w.w); }
#pragma unroll
        for (int i = 0; i < 8; ++i) red[rg * 512 + ct * 8 + i] = s[i];
        __syncthreads();
        { const int c = F.tid; float t = 0.f;
#pragma unroll
          for (int g = 0; g < 8; ++g) t += red[g * 512 + c];
          kmean[(size_t)bj * 1024 + half * 512 + c] = t * (1.0f / 256.0f); }
        __syncthreads();
    }
}
__device__ __forceinline__ bool sel_better(float s, int j, float v, int i) { return s > v || (s == v && j < i); }
__device__ __forceinline__ void sel_insert(float s, int j, float& v0, int& i0, float& v1, int& i1, float& v2, int& i2) {
    const bool b0 = sel_better(s, j, v0, i0), b1 = sel_better(s, j, v1, i1), b2 = sel_better(s, j, v2, i2);
    v2 = b1 ? v1 : (b2 ? s : v2); i2 = b1 ? i1 : (b2 ? j : i2);
    v1 = b0 ? v0 : (b1 ? s : v1); i1 = b0 ? i0 : (b1 ? j : i1);
    v0 = b0 ? s : v0; i0 = b0 ? j : i0;
}
__device__ __forceinline__ void moba_select_phase(Frame& F, const bf16* MQ, const float* kmean, unsigned* sel) {
    const int qn = F.lane & 15, kg = F.lane >> 4;
    for (int u = F.vcu; u < BATCH * MOBA_NB * MOBA_H; u += F.G) {
        const int a_ = u & 7, bh_ = (u >> 3) & 31, k_ = u >> 8, qi = a_ + 8 * k_, h = bh_ & 7, b = bh_ >> 3;
        const size_t q0 = (size_t)b * SEQ + (size_t)qi * 256 + F.wave * 32;
        unsigned mask[2] = {0u, 0u};
        if (qi > 0) {
            moba::bf16x8 qf[2][4];
#pragma unroll
            for (int cg = 0; cg < 2; ++cg)
#pragma unroll
                for (int ks = 0; ks < 4; ++ks) qf[cg][ks] = *reinterpret_cast<const moba::bf16x8*>(MQ + (q0 + cg * 16 + qn) * 1024 + h * 128 + ks * 32 + kg * 8);
            f32x4 acc[2][2];
#pragma unroll
            for (int rg = 0; rg < 2; ++rg) { acc[rg][0] = (f32x4){0.f, 0.f, 0.f, 0.f}; acc[rg][1] = (f32x4){0.f, 0.f, 0.f, 0.f}; }
#pragma unroll
            for (int rg = 0; rg < 2; ++rg) {
                if (rg * 16 < qi) {
#pragma unroll
                    for (int ks = 0; ks < 4; ++ks) {
                        const float* kp = kmean + (size_t)(b * 32 + rg * 16 + qn) * 1024 + h * 128 + ks * 32 + kg * 8;
                        const f32x4 k0 = *reinterpret_cast<const f32x4*>(kp), k1 = *reinterpret_cast<const f32x4*>(kp + 4);
                        float kv[8] = {k0.x, k0.y, k0.z, k0.w, k1.x, k1.y, k1.z, k1.w};
                        unsigned t[3][4];
#pragma unroll
                        for (int p = 0; p < 3; ++p)
#pragma unroll
                            for (int e = 0; e < 4; ++e) { const unsigned w = pg8::cvt_pk_bf16(kv[2 * e], kv[2 * e + 1]); t[p][e] = w; kv[2 * e] -= pg8::bf_lo(w); kv[2 * e + 1] -= pg8::bf_hi(w); }
#pragma unroll
                        for (int p = 0; p < 3; ++p) { moba::u32x4 w = {t[p][0], t[p][1], t[p][2], t[p][3]}; const moba::bf16x8 af = *reinterpret_cast<moba::bf16x8*>(&w);
                            acc[rg][0] = __builtin_amdgcn_mfma_f32_16x16x32_bf16(af, qf[0][ks], acc[rg][0], 0, 0, 0);
                            acc[rg][1] = __builtin_amdgcn_mfma_f32_16x16x32_bf16(af, qf[1][ks], acc[rg][1], 0, 0, 0); }
                    }
                }
            }
#pragma unroll
            for (int cg = 0; cg < 2; ++cg) {
                float v0 = -INFINITY, v1 = -INFINITY, v2 = -INFINITY; int i0 = 64, i1 = 64, i2 = 64;
#pragma unroll
                for (int rg = 0; rg < 2; ++rg)
#pragma unroll
                    for (int r = 0; r < 4; ++r) { const int j = rg * 16 + kg * 4 + r; const bool ok = j < qi; sel_insert(ok ? acc[rg][cg][r] : -INFINITY, ok ? j : 64, v0, i0, v1, i1, v2, i2); }
#pragma unroll
                for (int o = 16; o < 64; o <<= 1) {
                    const float w0 = __shfl_xor(v0, o), w1 = __shfl_xor(v1, o), w2 = __shfl_xor(v2, o); const int j0 = __shfl_xor(i0, o), j1 = __shfl_xor(i1, o), j2 = __shfl_xor(i2, o);
                    sel_insert(w0, j0, v0, i0, v1, i1, v2, i2); sel_insert(w1, j1, v0, i0, v1, i1, v2, i2); sel_insert(w2, j2, v0, i0, v1, i1, v2, i2); }
                mask[cg] = (i0 < 32 ? 1u << i0 : 0u) | (i1 < 32 ? 1u << i1 : 0u) | (i2 < 32 ? 1u << i2 : 0u);
            }
        }
        if (kg < 2) sel[(size_t)(b * MOBA_H + h) * SEQ + qi * 256 + F.wave * 32 + kg * 16 + qn] = kg ? mask[1] : mask[0];
    }
}
__device__ __forceinline__ void moba_partial_phase(Frame& F, const bf16* MQ, const bf16* MK, const bf16* MV, const unsigned* sel, const moba::PartBufs& PB, gu32* ctr) {
    LAS unsigned* box = (LAS unsigned*)(F.lds + moba::P_BOX);
    for (;;) {
        if (F.tid == 0) box[0] = __hip_atomic_fetch_add(ctr, 1u, __ATOMIC_RELAXED, __HIP_MEMORY_SCOPE_AGENT);
        __syncthreads();
        const int k = (int)box[0];
        if (k >= 31 * 32) break;
        moba::partial_unit(MQ, MK, MV, sel, PB, (k & 31) >> 3, k & 7, k >> 5, F.lds);
    }
}
__device__ __forceinline__ void moba_own_phase(Frame& F, const bf16* MQ, const bf16* MK, const bf16* MV, bf16* OB, const unsigned* sel, const moba::PartBufs& PB) {
    for (int u = F.vcu; u < BATCH * MOBA_H * MOBA_NB; u += F.G) {
        const int qi = u & 31, h = (u >> 5) & 7, b = u >> 8;
        const float sl2 = __builtin_amdgcn_exp2f(-(float)(h + 1)) * moba::LOG2E;
        const size_t qrow = (size_t)b * SEQ + (size_t)qi * 256;
        moba::unit(MQ + qrow * 1024 + h * 128, MK + (size_t)b * SEQ * 1024 + h * 128, MV + (size_t)b * SEQ * 1024 + h * 128, OB,
                   sel + (size_t)(b * MOBA_H + h) * SEQ + qi * 256, PB, (size_t)(b * MOBA_H + h) * SEQ + qi * 256, qi, sl2, F.lds + RING_OFF, (int)qrow, h * 128);
    }
}

struct Args { const float* in[18]; float* out; unsigned char* ws; int ph_lo, ph_hi, li, pad; };
enum { I_X = 0, I_N1, I_WG1, I_WU1, I_WD1, I_NMIX, I_WIN, I_WALPHA, I_BALPHA, I_GONORM, I_WBG, I_WBM, I_WOUT, I_N2, I_WG2, I_WU2, I_WD2, I_NF };

__global__ void __launch_bounds__(NWAVES * 64, 2) mk_fwd(Args args) {
    extern __shared__ __attribute__((aligned(16))) unsigned char lds[];
    Frame F;
    F.lds = (LAS unsigned char*)lds;
    F.MISC = (volatile LAS unsigned*)(F.lds + MISC_OFF);
    F.tid = threadIdx.x; F.lane = F.tid & 63; F.wave = __builtin_amdgcn_readfirstlane(F.tid >> 6);
    F.G = gridDim.x; { const int bx = blockIdx.x; F.vcu = (F.G % 8 == 0) ? (bx % 8) * (F.G / 8) + bx / 8 : bx; }
    unsigned char* ws = args.ws;
    F.ctl = (gu32*)(ws + WS_CTL);
    for (int u = F.tid; u < (LDS_BYTES - LDSCTL_OFF) / 4; u += NWAVES * 64) ((LAS unsigned*)(F.lds + LDSCTL_OFF))[u] = 0u;
    __syncthreads();
    XcdBarrier bar; bar.bar = (unsigned*)(F.ctl + CW_BAR); bar.x = 0; bar.st = nullptr;
    if (!MK_PER_PHASE) bar = xcd_barrier_post((unsigned*)(F.ctl + CW_BAR), F.MISC + 8);
#define GRID_BAR() do { if (!MK_PER_PHASE) xcd_barrier(bar); } while (0)
    const int lo = args.ph_lo, hi = args.ph_hi;
#define REP(id, ...) do { __VA_ARGS__; if (MK_PROBE_ID == (id)) { __VA_ARGS__; } } while (0)
#define IN(k) (lo <= (k) && (k) < hi)
#define BOTH(k) (IN(k) && IN((k) + 1))
    const float* x = args.in[I_X]; float* out = args.out;
    bf16* WGU = (bf16*)(ws + WS_WGU); bf16* WD = (bf16*)(ws + WS_WD); bf16* WIN = (bf16*)(ws + WS_WIN); bf16* WBG = (bf16*)(ws + WS_WBG); bf16* WBM = (bf16*)(ws + WS_WBM); bf16* WO = (bf16*)(ws + WS_WO); bf16* WD1A = (bf16*)(ws + WS_WD1);
    bf16* XN = (bf16*)(ws + WS_XN); bf16* HID = (bf16*)(ws + WS_R1); unsigned char* R1 = ws + WS_R1;
    bf16* OA = XN; bf16* OB = XN + (size_t)M * 1024; bf16* YM = (bf16*)(R1 + R1_GQ);
    float* SQP = (float*)(ws + WS_PSTAT);
    float* RS0 = (float*)(ws + WS_MISC + 3 * MiB); float* RS1 = RS0 + M; float* RS2 = RS1 + M;
    bf16* X1 = (bf16*)out; bf16* X2 = (bf16*)(R1 + R1_GA); bf16* X3 = XN;

    if (IN(0)) {
        REP(1, { int cur = 0;
        transpose_weight(F, args.in[I_WG1], DM, DFF, WGU, MapGU{0}, cur, 0, args.in[I_N1]);
        transpose_weight(F, args.in[I_WU1], DM, DFF, WGU, MapGU{1}, cur, 0, args.in[I_N1]);
        transpose_weight(F, args.in[I_WD1], DFF, DM, WD, MapId{}, cur);
        transpose_weight(F, args.in[I_WIN], DM, D_IN, WIN, MapIn{}, cur, 0, args.in[I_NMIX]);
        transpose_weight(F, args.in[I_WBG], 1024, DM, WBG, MapId{}, cur);
        transpose_weight(F, args.in[I_WBM], 1024, DM, WBM, MapId{}, cur);
        transpose_weight(F, args.in[I_WOUT], DM, DM, WO, MapId{}, cur);
        zero_rows_tiled(F, WIN, D_IN, NPROJ, DM); });
        REP(2, rs_pass<2>(F, LdRowF32{x, F.lane}, StRowBf16{XN, F.lane}, RS0));
        if (BOTH(0)) GRID_BAR();
    }
    constexpr int MH = M;
#define FFN_GU(half, XNp, LDH, RSp) do { pg8::Gemm g{(XNp) + (size_t)(half) * MH * DM, WGU, MH, 2 * DFF, DM}; pg8::StaticOrder S; S.init(MH, 2 * DFF, F.G, (int)blockIdx.x); \
        pg8::EpiSwiGLU E{HID + (size_t)(half) * MH * (LDH), (LDH), (RSp)}; pg8::gemm_phase<pg8::EpiSwiGLU, pg8::StaticOrder, true, true>(F.lds + RING_OFF, g, S, E); } while (0)
#define FFN_DOWN(half, RF32, Rp, Op) do { pg8::Gemm g{HID + (size_t)(half) * MH * DFF, WD, MH, DM, DFF}; pg8::StaticOrder S; S.init(MH, DM, F.G, (int)blockIdx.x, 4); \
        pg8::EpiResidBf<RF32> E{(Rp) + (size_t)(half) * MH * DM, (Op) + (size_t)(half) * MH * DM, DM, 0.5f, SQP}; pg8::gemm_phase<pg8::EpiResidBf<RF32>, pg8::StaticOrder, true, true>(F.lds + RING_OFF, g, S, E); } while (0)
    if (IN(1)) { FFN_GU(0, XN, DFF, RS0); if (BOTH(1)) GRID_BAR(); }
    if (IN(2)) { REP(3, FFN_DOWN(0, false, XN, X1)); if (BOTH(2)) GRID_BAR(); }
    if (IN(3)) {
        REP(4, rs_finalize(F, SQP, RS1));
        if (BOTH(3)) GRID_BAR();
    }
    if (IN(4)) {
        pg8::Gemm g{X1, WIN, M, NPROJ, DM}; pg8::StaticOrder S; S.init(M, NPROJ, F.G, (int)blockIdx.x);
        pg8::EpiProj E{R1, RS1, (float*)(ws + WS_CTL + 512 * 1024)};
        REP(5, pg8::gemm_phase<pg8::EpiProj, pg8::StaticOrder, true, true>(F.lds + RING_OFF, g, S, E));
        if (BOTH(4)) GRID_BAR();
    }
    const bf16* MQ = (const bf16*)(R1 + R1_MQ); const bf16* MKp = (const bf16*)(R1 + R1_MK); const bf16* MV = (const bf16*)(R1 + R1_MV);
    float* KMEAN = (float*)(ws + WS_CTL + 512 * 1024);      unsigned* SEL = (unsigned*)(ws + WS_MISC + MISC_SEL);
    const gla::Tensors GX{(const bf16*)(R1 + R1_GQ), (const bf16*)(R1 + R1_GK), (const bf16*)(R1 + R1_GV), (const bf16*)(R1 + R1_GR), (const float*)(R1 + R1_GLR),
                          args.in[I_WALPHA], args.in[I_BALPHA], args.in[I_GONORM], (bf16*)(ws + WS_GLAS), (float*)(ws + WS_MISC + MISC_DEC), OA, (bf16*)(ws + WS_WGU), (bf16*)(ws + WS_WGU + 32 * MiB)};
    const moba::PartBufs PB{(bf16*)(R1 + R1_GQ), (float*)(ws + WS_PSTAT), (float*)(ws + WS_PSTAT + 3 * MiB)};
    if (IN(5)) { REP(6, gla_pass<false>(F, GX)); REP(8, moba_select_phase(F, MQ, KMEAN, SEL)); if (BOTH(5)) GRID_BAR(); }
    if (IN(6)) { gla_scan(F, GX); if (BOTH(6)) GRID_BAR(); }
    if (IN(7)) { REP(9, gla_pass<true>(F, GX)); if (BOTH(7)) GRID_BAR(); }
    if (IN(8)) { moba_partial_phase(F, MQ, MKp, MV, SEL, PB, F.ctl + CW_QUEUE); if (MK_PROBE_ID == 10) moba_partial_phase(F, MQ, MKp, MV, SEL, PB, F.ctl + CW_QUEUE + 64); if (BOTH(8)) GRID_BAR(); }
    if (IN(9)) { REP(11, moba_own_phase(F, MQ, MKp, MV, OB, SEL, PB)); if (BOTH(9)) GRID_BAR(); }
    if (IN(10)) {
        REP(12, {
        { pg8::Gemm g{OA, WBG, M, DM, 1024}; pg8::StaticOrder S; S.init(M, DM, F.G, (int)blockIdx.x, 4);
          pg8::EpiGateMul<false> E{(bf16*)(R1 + R1_GA), (bf16*)(R1 + R1_GA), YM, DM};
          pg8::gemm_phase<pg8::EpiGateMul<false>, pg8::StaticOrder, true, true>(F.lds + RING_OFF, g, S, E); }
        { pg8::Gemm g{OB, WBM, M, DM, 1024}; pg8::StaticOrder S; S.init(M, DM, F.G, (int)blockIdx.x, 4);
          pg8::EpiGateMul<true> E{(bf16*)(R1 + R1_GB), (bf16*)(R1 + R1_GA), YM, DM};
          pg8::gemm_phase<pg8::EpiGateMul<true>, pg8::StaticOrder, true, true>(F.lds + RING_OFF, g, S, E); } });
        if (BOTH(10)) GRID_BAR();
    }
    if (IN(11)) {
        pg8::Gemm g{YM, WO, M, DM, DM}; pg8::StaticOrder S; S.init(M, DM, F.G, (int)blockIdx.x, 4);
        pg8::EpiResidBf<false> E{X1, X2, DM, 1.0f, SQP};
        REP(13, pg8::gemm_phase<pg8::EpiResidBf<false>, pg8::StaticOrder, true, true>(F.lds + RING_OFF, g, S, E));
        if (MK_PROBE_ID == 18) { pg8::EpiStoreBf E2{(bf16*)(R1 + R1_GA), DM, 1.0f}; pg8::gemm_phase<pg8::EpiStoreBf, pg8::StaticOrder, true, true>(F.lds + RING_OFF, g, S, E2); }
        if (BOTH(11)) GRID_BAR();
    }
    if (IN(12)) {
        REP(14, { int cur = 0;
        transpose_weight(F, args.in[I_WG2], DM, DFF, WGU, MapGU{0}, cur, 0, args.in[I_N2]);
        transpose_weight(F, args.in[I_WU2], DM, DFF, WGU, MapGU{1}, cur, 0, args.in[I_N2]);
        transpose_weight(F, args.in[I_WD2], DFF, DM, WD, MapId{}, cur); });
        REP(15, rs_finalize(F, SQP, RS2));
        if (BOTH(12)) GRID_BAR(); }
    if (IN(13)) { FFN_GU(0, X2, DFF, RS2); if (BOTH(13)) GRID_BAR(); }
#define FFN_DOWN_NR(half, Op) do { pg8::Gemm g{HID + (size_t)(half) * MH * DFF, WD, MH, DM, DFF}; pg8::StaticOrder S; S.init(MH, DM, F.G, (int)blockIdx.x, 4); \
        pg8::EpiStoreBf E{(Op) + (size_t)(half) * MH * DM, DM, 0.5f}; pg8::gemm_phase<pg8::EpiStoreBf, pg8::StaticOrder, true, true>(F.lds + RING_OFF, g, S, E); } while (0)
    if (IN(14)) { FFN_DOWN_NR(0, X3); if (BOTH(14)) GRID_BAR(); }
#undef FFN_DOWN_NR
#undef FFN_GU
#undef FFN_DOWN
    if (IN(15)) { REP(16, rms_pass<2>(F, args.in[I_NF], LdRowBf16SumT{X2, X3, F.lane}, StRowF32{out, F.lane})); }
#undef IN
#undef BOTH
}

extern "C" void kernel_launch(void* const* d_in, const int* in_sizes, int n_in, void* d_out, int out_size, void* d_ws, size_t ws_size, hipStream_t stream) {
    static int grid = 0;
    if (grid == 0) {
        if (n_in != 18 || in_sizes[0] != M * DM || out_size != M * DM || ws_size < WS_END) { fprintf(stderr, "kernel_launch: unexpected shapes (n_in %d, in0 %d, out %d, ws %zu < %zu)\n", n_in, n_in > 0 ? in_sizes[0] : -1, out_size, ws_size, (size_t)WS_END); grid = -1; return; }
        int dev = 0, cus = 0, per_cu = 0;
        if (hipGetDevice(&dev) != hipSuccess || hipDeviceGetAttribute(&cus, hipDeviceAttributeMultiprocessorCount, dev) != hipSuccess) { grid = -1; return; }
        if (hipFuncSetAttribute((const void*)mk_fwd, hipFuncAttributeMaxDynamicSharedMemorySize, LDS_BYTES) != hipSuccess) { fprintf(stderr, "kernel_launch: hipFuncSetAttribute failed\n"); grid = -1; return; }
        if (hipOccupancyMaxActiveBlocksPerMultiprocessor(&per_cu, (const void*)mk_fwd, NWAVES * 64, LDS_BYTES) != hipSuccess || per_cu < 1) { fprintf(stderr, "kernel_launch: occupancy query says %d\n", per_cu); }
        (void)hipGetLastError();
        grid = cus;
    }
    if (grid < 0) return;
    if (hipMemsetAsync((char*)d_ws + WS_CTL, 0, CTL_ZERO_BYTES, stream) != hipSuccess) return;
    Args a{};
    for (int i = 0; i < 18; ++i) a.in[i] = (const float*)d_in[i];
    a.out = (float*)d_out; a.ws = (unsigned char*)d_ws; a.pad = 0;
#if MK_PER_PHASE
    for (int p = 0; p < N_PHASES; ++p) { a.ph_lo = p; a.ph_hi = p + 1; a.li = p; hipLaunchKernelGGL(mk_fwd, dim3(grid), dim3(NWAVES * 64), LDS_BYTES, stream, a); }
#else
    a.ph_lo = 0; a.ph_hi = N_PHASES; a.li = 0;
    hipLaunchKernelGGL(mk_fwd, dim3(grid), dim3(NWAVES * 64), LDS_BYTES, stream, a);
#endif
    const hipError_t le = hipPeekAtLastError();
    if (le != hipSuccess) fprintf(stderr, "kernel_launch: launch failed: %s\n", hipGetErrorName(le));
}
```
